# Optimizing an MI355X kernel written in HIP

```python
import jax, jax.numpy as jnp
from jax import lax
import numpy as np

D_MODEL = 2048
BATCH = 2
SEQ = 4096
DEPTH = 1

MIX_WIDTH = D_MODEL
FOURIER_HEAD_DIM = 128
FOURIER_HEADS = (MIX_WIDTH // 2) // FOURIER_HEAD_DIM
FOURIER_WIDTH = FOURIER_HEADS * FOURIER_HEAD_DIM
GMLP_HEAD_DIM = 128
GMLP_HEADS = (MIX_WIDTH - FOURIER_WIDTH) // GMLP_HEAD_DIM
GMLP_WIDTH = GMLP_HEADS * GMLP_HEAD_DIM
CHUNK = 128
IN_WIDTH = FOURIER_WIDTH + 2 * GMLP_WIDTH
D_FF = (-(-8 * D_MODEL // (3 * 256))) * 256
EPS = 1e-6

kernel_name = "hybrid_fnet_gmlp_encoder_block"


def rmsnorm(x, g):
    xf = x.astype(jnp.float32)
    y = xf * lax.rsqrt(jnp.mean(xf * xf, axis=-1, keepdims=True) + EPS)
    return (y * g.astype(jnp.float32)).astype(x.dtype)


def fourier_mixer(a, w_fourier):
    b, s, _ = a.shape
    a4 = a.reshape(b, s, FOURIER_HEADS, FOURIER_HEAD_DIM).astype(jnp.float32)
    f = jnp.fft.fftn(a4, axes=(1, 3), norm="ortho").real.astype(a.dtype)
    f = jnp.einsum("bshd,hde->bshe", f, w_fourier)
    return f.reshape(b, s, FOURIER_WIDTH)


def spatial_gating_mixer(u, v, g_sgu, w_spatial, b_spatial):
    b, s, _ = v.shape
    v = rmsnorm(v, g_sgu)
    v5 = v.reshape(b, s // CHUNK, CHUNK, GMLP_HEADS, GMLP_HEAD_DIM)
    sv = jnp.einsum("hpq,bnqhd->bnphd", w_spatial, v5)
    sv = sv + jnp.transpose(b_spatial)[None, None, :, :, None]
    return u * sv.reshape(b, s, GMLP_WIDTH)


def setup_inputs(seed: int = 0) -> dict:
    key = jax.random.key(seed)
    ks = jax.random.split(key, 16)
    f32 = jnp.float32
    L = DEPTH
    x = jax.random.normal(ks[0], (BATCH, SEQ, D_MODEL), f32)
    norm_mix = 1.0 + 0.02 * jax.random.normal(ks[1], (L, D_MODEL), f32)
    w_in = jax.random.normal(ks[2], (L, D_MODEL, IN_WIDTH), f32) * D_MODEL ** -0.5
    w_fourier = jax.random.normal(ks[3], (L, FOURIER_HEADS, FOURIER_HEAD_DIM, FOURIER_HEAD_DIM), f32) * FOURIER_HEAD_DIM ** -0.5
    sgu_norm = 1.0 + 0.02 * jax.random.normal(ks[4], (L, GMLP_WIDTH), f32)
    w_spatial = jax.random.normal(ks[5], (L, GMLP_HEADS, CHUNK, CHUNK), f32) * CHUNK ** -0.5
    b_spatial = 1.0 + 0.02 * jax.random.normal(ks[6], (L, GMLP_HEADS, CHUNK), f32)
    w_out = jax.random.normal(ks[7], (L, MIX_WIDTH, D_MODEL), f32) * MIX_WIDTH ** -0.5
    norm_ffn = 1.0 + 0.02 * jax.random.normal(ks[8], (L, D_MODEL), f32)
    w_gate = jax.random.normal(ks[9], (L, D_MODEL, D_FF), f32) * D_MODEL ** -0.5
    w_up = jax.random.normal(ks[10], (L, D_MODEL, D_FF), f32) * D_MODEL ** -0.5
    w_down = jax.random.normal(ks[11], (L, D_FF, D_MODEL), f32) * D_FF ** -0.5
    norm_final = 1.0 + 0.02 * jax.random.normal(ks[12], (D_MODEL,), f32)
    return {"x": x, "norm_mix": norm_mix, "w_in": w_in, "w_fourier": w_fourier,
            "sgu_norm": sgu_norm, "w_spatial": w_spatial, "b_spatial": b_spatial,
            "w_out": w_out, "norm_ffn": norm_ffn, "w_gate": w_gate, "w_up": w_up,
            "w_down": w_down, "norm_final": norm_final}


def reference(x, norm_mix, w_in, w_fourier, sgu_norm, w_spatial, b_spatial, w_out,
              norm_ffn, w_gate, w_up, w_down, norm_final):
    for l in range(DEPTH):
        h = rmsnorm(x, norm_mix[l])
        z = h @ w_in[l]
        a = z[..., :FOURIER_WIDTH]
        uv = jax.nn.gelu(z[..., FOURIER_WIDTH:])
        u = uv[..., :GMLP_WIDTH]
        v = uv[..., GMLP_WIDTH:]
        y_f = fourier_mixer(a, w_fourier[l])
        y_g = spatial_gating_mixer(u, v, sgu_norm[l], w_spatial[l], b_spatial[l])
        x = x + jnp.concatenate([y_f, y_g], axis=-1) @ w_out[l]
        h2 = rmsnorm(x, norm_ffn[l])
        x = x + (jax.nn.silu(h2 @ w_gate[l]) * (h2 @ w_up[l])) @ w_down[l]
    return rmsnorm(x, norm_final)
```

```cpp
#include <hip/hip_runtime.h>
#include <cstdio>
#include <cstdint>
namespace pg8 {
#define PG8_LAS __attribute__((address_space(3)))
typedef unsigned short bf16_t;
typedef short bf16x8 __attribute__((ext_vector_type(8)));
typedef float f32x4 __attribute__((ext_vector_type(4)));
typedef float f32x2 __attribute__((ext_vector_type(2)));
typedef unsigned u32x4 __attribute__((ext_vector_type(4)));
typedef unsigned u32x2 __attribute__((ext_vector_type(2)));
constexpr int BM = 256, BK = 64, HALF = 128, HTB = HALF * BK * 2  , STAGE_BYTES = 8 * HTB, NXCD = 8, WGM = 8;

__host__ __device__ __forceinline__ int lds_byte(int r, int c) { const int st = (r >> 4) * 2 + (c >> 5), rr = r & 15, cc = c & 31, ob = rr * 64 + cc * 2; return st * 1024 + (ob ^ (((ob >> 9) & 1) << 5)); }
__host__ __device__ __forceinline__ void stage_rc(int b, int& R, int& C) { const int st = b / 1024, sb = b % 1024, swz = sb ^ (((sb >> 9) & 1) << 5); R = (st >> 1) * 16 + swz / 64; C = (st & 1) * 32 + (swz % 64) / 2; }
__host__ __device__ __forceinline__ int perm32(int rho) { const int n = rho >> 4, i = rho & 15; return 8 * (i >> 2) + 4 * n + (i & 3); }

struct Unit { int pm, pn; };

struct Order {
    int nM, nN, nwg, G, c; const char* A; const char* B; size_t tstep; int swap_from;
    __device__ void init(int M, int N, int K, int G_, int c_, const void* A_, const void* B_, int swap_from_ = 1 << 30) { nM = M / BM; nN = N / BM; nwg = nM * nN; G = G_; c = c_; A = (const char*)A_; B = (const char*)B_; tstep = (size_t)BM * K * 2; swap_from = swap_from_; }
    __device__ bool next(int i, Unit& u) const {
        const long L = (long)i * G + c; if (L >= nwg) return false;
        int wgid = (int)L; { const int q = nwg / NXCD, r = nwg % NXCD, xcd = wgid % NXCD, off = wgid / NXCD; wgid = (xcd < r ? xcd * (q + 1) : r * (q + 1) + (xcd - r) * q) + off; }
        const int nig = WGM * nN, gid = wgid / nig, fm = gid * WGM, gsz = (nM - fm) < WGM ? (nM - fm) : WGM;
        u.pm = fm + ((wgid % nig) % gsz); u.pn = (wgid % nig) / gsz; return true;
    }
    __device__ __forceinline__ const char* aptr(const Unit& u) const { return u.pn >= swap_from ? B + (size_t)u.pn * tstep : A + (size_t)u.pm * tstep; }
    __device__ __forceinline__ const char* bptr(const Unit& u) const { return u.pn >= swap_from ? A + (size_t)u.pm * tstep : B + (size_t)u.pn * tstep; }
    __device__ __forceinline__ void a_ready(const Unit&) const {}
    __device__ __forceinline__ void done(const Unit&) const {}
};

typedef __bf16 bf16x2_t __attribute__((ext_vector_type(2)));
__device__ __forceinline__ unsigned cvt_pk_bf16(float lo, float hi) { f32x2 v = {lo, hi}; bf16x2_t b = __builtin_convertvector(v, bf16x2_t); return __builtin_bit_cast(unsigned, b); }
__device__ __forceinline__ u32x4 pack8(const f32x4 v0, const f32x4 v1) { u32x4 w; w.x = cvt_pk_bf16(v0[0], v0[1]); w.y = cvt_pk_bf16(v0[2], v0[3]); w.z = cvt_pk_bf16(v1[0], v1[1]); w.w = cvt_pk_bf16(v1[2], v1[3]); return w; }
__device__ __forceinline__ float gelu_t(float x) { const float u = x * (0.7978845608f + 0.0356774081f * x * x); return x * __builtin_amdgcn_rcpf(1.0f + __builtin_amdgcn_exp2f(-2.8853900818f * u)); }
__device__ __forceinline__ f32x4 gelu4(f32x4 v) { return (f32x4){gelu_t(v[0]), gelu_t(v[1]), gelu_t(v[2]), gelu_t(v[3])}; }
__device__ __forceinline__ float silu_f(float x) { return x * __builtin_amdgcn_rcpf(1.0f + __builtin_amdgcn_exp2f(-1.4426950409f * x)); }


struct EpiIn {
    static constexpr bool PERM = true, AFTER_DRAIN = false;
    bf16_t* Abuf; bf16_t* Ubuf; bf16_t* VT; const float* rstd1;
    __device__ __forceinline__ void operator()(const f32x4 (&acc)[2][2][4][2], const Unit& u, int wr, int wc, int fr, int fq) const {
        const int kind = u.pn >> 2;
        if (kind < 2) {
            bf16_t* base = kind == 0 ? Abuf : Ubuf;
            const int row0 = u.pm * BM + wr * 64 + fr, col0 = (u.pn & 3) * BM + wc * 32 + 8 * fq;
#pragma unroll
            for (int ai = 0; ai < 2; ++ai)
#pragma unroll
                for (int m = 0; m < 4; ++m) { const int row = row0 + ai * HALF + m * 16; const float rs = rstd1[row]; bf16_t* rowp = base + (size_t)row * 1024 + col0;
#pragma unroll
                    for (int bj = 0; bj < 2; ++bj) { f32x4 v0 = acc[ai][bj][m][0] * rs, v1 = acc[ai][bj][m][1] * rs;
                        if (kind == 1) { v0 = gelu4(v0); v1 = gelu4(v1); }
                        *(u32x4*)(rowp + bj * HALF) = pack8(v0, v1); } }
        } else {
            const int f0 = (u.pn - 8) * BM + wr * 64 + fr, t0 = u.pm * BM + wc * 32 + 8 * fq;
            f32x4 rs[2][2];
#pragma unroll
            for (int bj = 0; bj < 2; ++bj) { rs[bj][0] = *(const f32x4*)(rstd1 + t0 + bj * HALF); rs[bj][1] = *(const f32x4*)(rstd1 + t0 + bj * HALF + 4); }
#pragma unroll
            for (int ai = 0; ai < 2; ++ai)
#pragma unroll
                for (int m = 0; m < 4; ++m) { bf16_t* rowp = VT + (size_t)(f0 + ai * HALF + m * 16) * 8192 + t0;
#pragma unroll
                    for (int bj = 0; bj < 2; ++bj) { const f32x4 v0 = gelu4(acc[ai][bj][m][0] * rs[bj][0]), v1 = gelu4(acc[ai][bj][m][1] * rs[bj][1]);
                        *(u32x4*)(rowp + bj * HALF) = pack8(v0, v1); } }
        }
    }
};
struct EpiDft {
    static constexpr bool PERM = true, AFTER_DRAIN = false;
    bf16_t* Ycat;
    __device__ __forceinline__ void operator()(const f32x4 (&acc)[2][2][4][2], const Unit& u, int wr, int wc, int fr, int fq) const {
        const int row0 = (u.pn >> 2) * 4096 + u.pm * BM + wr * 64 + fr, col0 = (u.pn & 3) * BM + wc * 32 + 8 * fq;
#pragma unroll
        for (int ai = 0; ai < 2; ++ai)
#pragma unroll
            for (int m = 0; m < 4; ++m) { bf16_t* rowp = Ycat + (size_t)(row0 + ai * HALF + m * 16) * 2048 + col0;
#pragma unroll
                for (int bj = 0; bj < 2; ++bj) *(u32x4*)(rowp + bj * HALF) = pack8(acc[ai][bj][m][0], acc[ai][bj][m][1]); }
    }
};
struct EpiGU {
    static constexpr bool PERM = true, AFTER_DRAIN = false;
    bf16_t* Hb; const float* ss1;
    __device__ __forceinline__ void operator()(const f32x4 (&acc)[2][2][4][2], const Unit& u, int wr, int wc, int fr, int fq) const {
        const int row0 = u.pm * BM + wr * 64 + fr, col0 = u.pn * HALF + wc * 32 + 8 * fq;
#pragma unroll
        for (int ai = 0; ai < 2; ++ai)
#pragma unroll
            for (int m = 0; m < 4; ++m) { const int row = row0 + ai * HALF + m * 16;
                const f32x4 p0 = *(const f32x4*)(ss1 + (size_t)row * 8), p1 = *(const f32x4*)(ss1 + (size_t)row * 8 + 4);
                const float ss = ((p0[0] + p0[1]) + (p0[2] + p0[3])) + ((p1[0] + p1[1]) + (p1[2] + p1[3]));
                const float r = 1.0f / sqrtf(ss * (1.0f / 2048.0f) + 1e-6f);
                f32x4 h0, h1;
#pragma unroll
                for (int j = 0; j < 4; ++j) { h0[j] = silu_f(acc[ai][0][m][0][j] * r) * (acc[ai][1][m][0][j] * r); h1[j] = silu_f(acc[ai][0][m][1][j] * r) * (acc[ai][1][m][1][j] * r); }
                *(u32x4*)(Hb + (size_t)row * 5632 + col0) = pack8(h0, h1); }
    }
};
template <bool WRITE_BF16> struct EpiRes {
    static constexpr bool PERM = true, AFTER_DRAIN = true;
    const float* base; float* out; bf16_t* outb; float* ssp;
    __device__ __forceinline__ void fused(f32x4 (&acc)[2][2][4][2], const Unit& u, int wr, int wc, int fr, int fq, PG8_LAS unsigned char* lds, int wid, int lane) const {
        PG8_LAS float* P = (PG8_LAS float*)lds;
        const int col0 = u.pn * BM + wc * 32 + 8 * fq;
#pragma unroll
        for (int ai = 0; ai < 2; ++ai)
#pragma unroll
            for (int m = 0; m < 4; ++m) { const int rl = ai * HALF + wr * 64 + m * 16 + fr; const size_t off = (size_t)(u.pm * BM + rl) * 2048 + col0; float ss = 0.f;
#pragma unroll
                for (int bj = 0; bj < 2; ++bj) { const f32x4 b0 = *(const f32x4*)(base + off + bj * HALF), b1 = *(const f32x4*)(base + off + bj * HALF + 4);
                    const f32x4 v0 = b0 + acc[ai][bj][m][0], v1 = b1 + acc[ai][bj][m][1];
                    *(f32x4*)(out + off + bj * HALF) = v0; *(f32x4*)(out + off + bj * HALF + 4) = v1;
                    if (WRITE_BF16) *(u32x4*)(outb + off + bj * HALF) = pack8(v0, v1);
                    ss += ((v0[0] * v0[0] + v0[1] * v0[1]) + (v0[2] * v0[2] + v0[3] * v0[3])) + ((v1[0] * v1[0] + v1[1] * v1[1]) + (v1[2] * v1[2] + v1[3] * v1[3])); }
                ss += __shfl_xor(ss, 16); ss += __shfl_xor(ss, 32);
                if (fq == 0) P[rl * 4 + wc] = ss;
                asm volatile("" ::: "memory"); }
        asm volatile("s_waitcnt lgkmcnt(0)" ::: "memory"); __builtin_amdgcn_s_barrier(); asm volatile("" ::: "memory");
        const int tid = wid * 64 + lane;
        if (tid < 256) { const f32x4 p = *(const PG8_LAS f32x4*)(P + tid * 4); ssp[(size_t)(u.pm * BM + tid) * 8 + u.pn] = (p[0] + p[1]) + (p[2] + p[3]); }
    }
};

template <class Epi, class Sched, bool ALIGN_EPI = false, bool SP2 = false>
__device__ __forceinline__ void gemm_phase(PG8_LAS unsigned char* lds, const int K, const Sched& S, const Epi& E) {
    const int tid = threadIdx.x, wid = __builtin_amdgcn_readfirstlane(tid >> 6), lane = tid & 63, wr = wid >> 2, wc = wid & 3, fr = lane & 15, fq = lane >> 4;
    const int nt = K / BK;
    unsigned voffA[2], voffB[2];
#pragma unroll
    for (int i = 0; i < 2; ++i) { int R, C; stage_rc(tid * 16 + i * 8192, R, C); const int Rb = Epi::PERM ? ((R & ~31) + perm32(R & 31)) : R;
        voffA[i] = (unsigned)(R * K + C) * 2u; voffB[i] = (unsigned)(Rb * K + C) * 2u; }
    const size_t kstep = (size_t)(BK * 2);
    const size_t hstep = (size_t)HALF * K * 2;
    const unsigned ldsw = (unsigned)wid * 1024u;
    const int aoff = lds_byte(wr * 64 + fr, fq * 8), boff = lds_byte(wc * 32 + fr, fq * 8);
#define PG8_SA(b, h) (((b) * 2 + (h)) * HTB)
#define PG8_SB(b, h) ((4 + (b) * 2 + (h)) * HTB)
#define PG8_STAGE(bufoff, gbase, voff) do { _Pragma("unroll") for (int _i = 0; _i < 2; ++_i) \
        __builtin_amdgcn_global_load_lds((const unsigned*)((const char*)(gbase) + (voff)[_i]), (PG8_LAS unsigned*)(lds + (bufoff) + ldsw + _i * 8192), 16, 0, 0); } while (0)
#define PG8_LDA(dst, b, h) do { _Pragma("unroll") for (int m = 0; m < 4; ++m) _Pragma("unroll") for (int k = 0; k < 2; ++k) dst[m][k] = *(const PG8_LAS bf16x8*)(lds + PG8_SA(b, h) + aoff + m * 2048 + k * 1024); } while (0)
#define PG8_LDB(dst, b, h) do { _Pragma("unroll") for (int n = 0; n < 2; ++n) _Pragma("unroll") for (int k = 0; k < 2; ++k) dst[n][k] = *(const PG8_LAS bf16x8*)(lds + PG8_SB(b, h) + boff + n * 2048 + k * 1024); } while (0)
#define PG8_MMA(ai, bj, At, Bt) do { __builtin_amdgcn_s_setprio(1); _Pragma("unroll") for (int m = 0; m < 4; ++m) _Pragma("unroll") for (int n = 0; n < 2; ++n) _Pragma("unroll") for (int k = 0; k < 2; ++k) \
        acc[ai][bj][m][n] = __builtin_amdgcn_mfma_f32_16x16x32_bf16(Bt[n][k], At[m][k], acc[ai][bj][m][n], 0, 0, 0); __builtin_amdgcn_s_setprio(0); } while (0)
#define PG8_WAIT_V(n) asm volatile("s_waitcnt vmcnt(" #n ")" ::: "memory")
#define PG8_WAIT_L(n) asm volatile("s_waitcnt lgkmcnt(" #n ")" ::: "memory")
#define PG8_BAR __builtin_amdgcn_s_barrier()
#define PG8_SCHED __builtin_amdgcn_sched_barrier(0)
    Unit cur, nxt; int ui = 0;
    if (!S.next(0, cur)) return;
    f32x4 acc[2][2][4][2];
#pragma unroll
    for (int a = 0; a < 2; ++a)
#pragma unroll
        for (int b = 0; b < 2; ++b)
#pragma unroll
            for (int m = 0; m < 4; ++m)
#pragma unroll
                for (int n = 0; n < 2; ++n) acc[a][b][m][n] = (f32x4){0.f, 0.f, 0.f, 0.f};
    bf16x8 At[4][2], B0[2][2], B1[2][2];
    const char* cA = S.aptr(cur); const char* cB = S.bptr(cur);
    S.a_ready(cur);
    if constexpr (SP2) {
        PG8_STAGE(PG8_SB(0, 0), cB, voffB); PG8_STAGE(PG8_SB(0, 1), cB + hstep, voffB); PG8_STAGE(PG8_SA(0, 0), cA, voffA); PG8_STAGE(PG8_SA(0, 1), cA + hstep, voffA);
        if (wr == 1) PG8_BAR;
        PG8_WAIT_V(2); PG8_BAR;
        PG8_STAGE(PG8_SB(1, 0), cB + kstep, voffB); PG8_STAGE(PG8_SA(1, 0), cA + kstep, voffA); PG8_STAGE(PG8_SB(1, 1), cB + hstep + kstep, voffB);
        PG8_WAIT_V(6); PG8_BAR;
    } else {
        PG8_STAGE(PG8_SB(0, 0), cB, voffB); PG8_STAGE(PG8_SA(0, 0), cA, voffA); PG8_STAGE(PG8_SB(0, 1), cB + hstep, voffB); PG8_STAGE(PG8_SA(0, 1), cA + hstep, voffA);
        if (wr == 1) PG8_BAR;
        PG8_WAIT_V(4); PG8_BAR;
        PG8_STAGE(PG8_SB(1, 0), cB + kstep, voffB); PG8_STAGE(PG8_SA(1, 0), cA + kstep, voffA); PG8_STAGE(PG8_SB(1, 1), cB + hstep + kstep, voffB);
        PG8_WAIT_V(6); PG8_BAR;
    }
    for (;;) {
        const bool has_next = S.next(ui + 1, nxt);
        const char* nA = has_next ? S.aptr(nxt) : cA; const char* nB = has_next ? S.bptr(nxt) : cB;
        for (int t = 0; t < nt; t += 2) {
            const bool last = (t == nt - 2);
            const char* a1 = cA + (size_t)(t + 1) * kstep;
            const char* a2 = last ? nA : cA + (size_t)(t + 2) * kstep; const char* b2 = last ? nB : cB + (size_t)(t + 2) * kstep;
            const char* a3 = a2 + kstep; const char* b3 = b2 + kstep;
            if (last && has_next) S.a_ready(nxt);
            if constexpr (SP2) {
            PG8_LDB(B0, 0, 0); PG8_LDB(B1, 0, 1); PG8_SCHED; PG8_LDA(At, 0, 0); PG8_STAGE(PG8_SA(1, 1), a1 + hstep, voffA);
            PG8_WAIT_V(8); PG8_WAIT_L(0); PG8_BAR; PG8_MMA(0, 0, At, B0); PG8_MMA(0, 1, At, B1); PG8_BAR; PG8_SCHED;
            PG8_LDA(At, 0, 1); PG8_STAGE(PG8_SB(0, 0), b2, voffB); PG8_STAGE(PG8_SB(0, 1), b2 + hstep, voffB); PG8_STAGE(PG8_SA(0, 0), a2, voffA);
            PG8_WAIT_V(8); PG8_WAIT_L(0); PG8_BAR; PG8_MMA(1, 0, At, B0); PG8_MMA(1, 1, At, B1); PG8_BAR; PG8_SCHED;
            PG8_LDB(B0, 1, 0); PG8_LDB(B1, 1, 1); PG8_SCHED; PG8_LDA(At, 1, 0); PG8_STAGE(PG8_SA(0, 1), a2 + hstep, voffA);
            PG8_WAIT_V(8); PG8_WAIT_L(0); PG8_BAR; PG8_MMA(0, 0, At, B0); PG8_MMA(0, 1, At, B1); PG8_BAR; PG8_SCHED;
            PG8_LDA(At, 1, 1); PG8_STAGE(PG8_SB(1, 0), b3, voffB); PG8_STAGE(PG8_SB(1, 1), b3 + hstep, voffB); PG8_STAGE(PG8_SA(1, 0), a3, voffA);
            PG8_WAIT_V(8); PG8_WAIT_L(0); PG8_BAR; PG8_MMA(1, 0, At, B0); PG8_MMA(1, 1, At, B1); PG8_BAR; PG8_SCHED;
            } else {
            PG8_LDB(B0, 0, 0); PG8_SCHED; PG8_LDA(At, 0, 0); PG8_STAGE(PG8_SA(1, 1), a1 + hstep, voffA);
            PG8_WAIT_L(8); PG8_BAR; PG8_WAIT_L(0); PG8_MMA(0, 0, At, B0); PG8_BAR; PG8_SCHED;
            PG8_LDB(B1, 0, 1); PG8_STAGE(PG8_SB(0, 0), b2, voffB);
            PG8_BAR; PG8_WAIT_L(0); PG8_MMA(0, 1, At, B1); PG8_BAR;
            PG8_LDA(At, 0, 1); PG8_STAGE(PG8_SA(0, 0), a2, voffA);
            PG8_BAR; PG8_WAIT_L(0); PG8_MMA(1, 0, At, B0); PG8_BAR; PG8_SCHED;
            PG8_STAGE(PG8_SB(0, 1), b2 + hstep, voffB);
            PG8_WAIT_V(6); PG8_BAR; PG8_MMA(1, 1, At, B1); PG8_BAR;
            PG8_LDB(B0, 1, 0); PG8_SCHED; PG8_LDA(At, 1, 0); PG8_STAGE(PG8_SA(0, 1), a2 + hstep, voffA);
            PG8_WAIT_L(8); PG8_BAR; PG8_WAIT_L(0); PG8_MMA(0, 0, At, B0); PG8_BAR; PG8_SCHED;
            PG8_LDB(B1, 1, 1); PG8_STAGE(PG8_SB(1, 0), b3, voffB);
            PG8_BAR; PG8_WAIT_L(0); PG8_MMA(0, 1, At, B1); PG8_BAR;
            PG8_LDA(At, 1, 1); PG8_STAGE(PG8_SA(1, 0), a3, voffA);
            PG8_BAR; PG8_WAIT_L(0); PG8_MMA(1, 0, At, B0); PG8_BAR; PG8_SCHED;
            PG8_STAGE(PG8_SB(1, 1), b3 + hstep, voffB);
            PG8_WAIT_V(6); PG8_BAR; PG8_MMA(1, 1, At, B1); PG8_BAR;
            }
        }
        if constexpr (ALIGN_EPI) { if (wr == 0) PG8_BAR; }
        if constexpr (!Epi::AFTER_DRAIN) { E(acc, cur, wr, wc, fr, fq); S.done(cur); }
        if (!has_next) break;
#pragma unroll
        for (int a = 0; a < 2; ++a)
#pragma unroll
            for (int b = 0; b < 2; ++b)
#pragma unroll
                for (int m = 0; m < 4; ++m)
#pragma unroll
                    for (int n = 0; n < 2; ++n) acc[a][b][m][n] = (f32x4){0.f, 0.f, 0.f, 0.f};
        cur = nxt; cA = nA; cB = nB; ++ui;
        if constexpr (ALIGN_EPI) { if (wr == 1) PG8_BAR; }
    }
    PG8_WAIT_V(0);
    if constexpr (!ALIGN_EPI) { if (wr == 0) PG8_BAR; }
    PG8_BAR;
    if constexpr (Epi::AFTER_DRAIN) { E.fused(acc, cur, wr, wc, fr, fq, lds, wid, lane); S.done(cur); }
#undef PG8_SA
#undef PG8_SB
#undef PG8_STAGE
#undef PG8_LDA
#undef PG8_LDB
#undef PG8_MMA
#undef PG8_WAIT_V
#undef PG8_WAIT_L
#undef PG8_BAR
#undef PG8_SCHED
}
}

namespace fp {
using pg8::bf16_t; using pg8::bf16x8; using pg8::f32x4; using pg8::u32x4; using pg8::u32x2;
constexpr int NWAVES = 8, NTHR = 512;
constexpr int SEQ = 4096, DM = 2048, MTOK = 8192, INW = 3072, FW = 1024, GW = 1024, DFF = 5632, NGU = 11264, KDFT = 8192;
constexpr float EPS = 1e-6f;
constexpr int NPHASE = 8;
#ifndef MK_PER_PHASE
#define MK_PER_PHASE 0
#endif

constexpr size_t MiB = 1u << 20;
constexpr size_t WS_CTL = 0, CTL_ZERO_BYTES = 64 * 1024;
constexpr size_t WS_WGU = 1 * MiB;
constexpr size_t WS_WD = 45 * MiB;
constexpr size_t WS_WOUT = 67 * MiB;
constexpr size_t WS_ADFT = 75 * MiB;
constexpr size_t WS_A = 139 * MiB;
constexpr size_t WS_U = 155 * MiB;
constexpr size_t WS_VT = 171 * MiB;
constexpr size_t WS_XB = 187 * MiB;
constexpr size_t WS_PT = 187 * MiB;
constexpr size_t WS_WIN = 219 * MiB;
constexpr size_t WS_YCAT = 219 * MiB;
constexpr size_t WS_SMALL = 251 * MiB;
constexpr size_t WS_RSTD1 = WS_SMALL;
constexpr size_t WS_SS1 = WS_SMALL + 64 * 1024;
constexpr size_t WS_SS2 = WS_SS1 + 256 * 1024;
constexpr size_t WS_CWT = WS_SMALL + 1 * MiB;
constexpr size_t WS_X1B = 187 * MiB;
constexpr size_t WS_H = 75 * MiB;
constexpr size_t WS_END = 256 * MiB;
static_assert(WS_WGU + (size_t)NGU * DM * 2 <= WS_WD && WS_WD + (size_t)DM * DFF * 2 <= WS_WOUT && WS_WOUT + (size_t)DM * DM * 2 <= WS_ADFT && WS_ADFT + (size_t)SEQ * KDFT * 2 <= WS_A, "ws map 1");
static_assert(WS_VT + (size_t)GW * MTOK * 2 <= WS_XB && WS_XB + (size_t)MTOK * DM * 2 <= WS_WIN && WS_YCAT + (size_t)MTOK * DM * 2 <= WS_SMALL && WS_CWT + 8 * 256 * 128 * 2 <= 253 * MiB, "ws map 2");
static_assert(WS_H + (size_t)MTOK * DFF * 2 <= WS_VT, "ws map 3");
constexpr int CW_BAR = 4096;

constexpr int RING_OFF = 0, RING_BYTES = 131072;
constexpr int LDSCTL_OFF = RING_BYTES, MISC_OFF = LDSCTL_OFF + 320;
constexpr int TAB_OFF = 135168;
constexpr int LDS_BYTES = 155648;
static_assert(TAB_OFF >= MISC_OFF + 128 && TAB_OFF + 16384 <= LDS_BYTES, "LDS map");

#define GAS __attribute__((address_space(1)))
#define LAS __attribute__((address_space(3)))
typedef GAS unsigned gu32;
#define RLX_AGENT __ATOMIC_RELAXED, __HIP_MEMORY_SCOPE_AGENT
#define LDS_WAIT() asm volatile("s_waitcnt lgkmcnt(0)" ::: "memory")
#define VM_WAIT() asm volatile("s_waitcnt vmcnt(0)" ::: "memory")
__device__ __forceinline__ unsigned f2bf(float f) { unsigned u = __builtin_bit_cast(unsigned, f); return (u + 0x7fffu + ((u >> 16) & 1u)) >> 16; }
__device__ __forceinline__ unsigned pk2(float lo, float hi) { return f2bf(lo) | (f2bf(hi) << 16); }
__device__ __forceinline__ float bf2f(unsigned short b) { return __builtin_bit_cast(float, (unsigned)b << 16); }

#define XB_TMO      128
#define XB_XCNT(j)  (256  + 64 * (j))
#define XB_XSUB(j)  (1280 + 64 * (j))
#define XB_XGEN(j)  (2304 + 64 * (j))
#define XB_TOP      3328
#define XB_TOPGEN   3392
#define XCD_BAR_WORDS 3456
#define XB_SPIN_CAP (1u << 22)
__device__ __forceinline__ unsigned xb_ld(unsigned* p)              { return __hip_atomic_load(p, __ATOMIC_RELAXED, __HIP_MEMORY_SCOPE_AGENT); }
__device__ __forceinline__ unsigned xb_add(unsigned* p, unsigned v) { return __hip_atomic_fetch_add(p, v, __ATOMIC_RELAXED, __HIP_MEMORY_SCOPE_AGENT); }
__device__ __forceinline__ unsigned xb_xcc_id() { return (unsigned)__builtin_amdgcn_s_getreg((3 << 11) | 20) & 0xFu; }
#define XB_SPIN(cond, bar) do { unsigned _sp = 0; while (cond) { __builtin_amdgcn_s_sleep(1); \
    if ((++_sp & 255u) == 0u) { if (xb_ld(&(bar)[XB_TMO])) break; if (_sp > XB_SPIN_CAP) { atomicAdd(&(bar)[XB_TMO], 1u); break; } } } } while (0)
struct XcdBarrier { unsigned* bar; unsigned x; volatile LAS unsigned* st; };
__device__ __forceinline__ XcdBarrier xcd_barrier_post(unsigned* bar, volatile LAS unsigned* st) {
    XcdBarrier b; b.bar = bar; b.x = xb_xcc_id(); b.st = st;
    if (threadIdx.x == 0) (void)xb_add(&bar[XB_XCNT(b.x)], 1u);
    return b;
}
__device__ __forceinline__ void xcd_barrier_complete(unsigned* bar, unsigned x, unsigned& nloc, unsigned& nx) {
    const unsigned G = gridDim.x * gridDim.y * gridDim.z;
    unsigned sum, cnt, mine, sp = 0u;
    for (;;) {
        sum = 0u; cnt = 0u; mine = 0u;
#pragma unroll
        for (unsigned j = 0; j < 16; ++j) { const unsigned c = xb_ld(&bar[XB_XCNT(j)]); sum += c; cnt += (c > 0u) ? 1u : 0u; mine = (j == x) ? c : mine; }
        if (sum == G) break;
        __builtin_amdgcn_s_sleep(1);
        if ((++sp & 255u) == 0u) { if (xb_ld(&bar[XB_TMO])) break; if (sp > XB_SPIN_CAP) { atomicAdd(&bar[XB_TMO], 1u); break; } }
    }
    nloc = mine > 0u ? mine : 1u; nx = cnt > 0u ? cnt : 1u;
}
__device__ __forceinline__ void xcd_barrier(const XcdBarrier& b) {
    asm volatile("s_waitcnt vmcnt(0)" ::: "memory");
    __syncthreads();
    if (threadIdx.x == 0) {
        unsigned* bar = b.bar;
        __builtin_amdgcn_s_waitcnt(0);
        unsigned nloc = b.st[0], nx = b.st[1];
        if (nloc == 0u) { xcd_barrier_complete(bar, b.x, nloc, nx); b.st[0] = nloc; b.st[1] = nx; }
        const unsigned old = xb_add(&bar[XB_XSUB(b.x)], 1u);
        const unsigned gen = old / nloc;
        if (old + 1u == (gen + 1u) * nloc) {
            __builtin_amdgcn_fence(__ATOMIC_RELEASE, "agent");
            asm volatile("s_waitcnt vmcnt(0)" ::: "memory");
            const unsigned og = xb_add(&bar[XB_TOP], 1u);
            const unsigned tg = og / nx;
            if (og + 1u == (tg + 1u) * nx) xb_add(&bar[XB_TOPGEN], 1u);
            else XB_SPIN(xb_ld(&bar[XB_TOPGEN]) == tg, bar);
            __builtin_amdgcn_fence(__ATOMIC_ACQUIRE, "agent");
            xb_add(&bar[XB_XGEN(b.x)], 1u);
            asm volatile("s_waitcnt vmcnt(0)" ::: "memory");
        } else {
            XB_SPIN(xb_ld(&bar[XB_XGEN(b.x)]) == gen, bar);
            __builtin_amdgcn_fence(__ATOMIC_ACQUIRE, "agent");
            asm volatile("s_waitcnt vmcnt(0)" ::: "memory");
        }
    }
    __syncthreads();
}

struct Args { const float* in[13]; float* out; unsigned char* ws; int ph_lo, ph_hi; };

__device__ __forceinline__ float wave_sum(float v) {
#pragma unroll
    for (int o = 1; o < 64; o <<= 1) v += __shfl_xor(v, o);
    return v;
}

__device__ __forceinline__ void p0_transpose_item(const float* W, int K, int N, bf16_t* WT, const float* g, LAS float* scr, int k0, int n0, int dst_row0, int lane) {
#pragma unroll 8
    for (int i = 0; i < 32; ++i) { const int kk = 2 * i + (lane >> 5); float v = W[(size_t)(k0 + kk) * N + n0 + (lane & 31)]; if (g) v *= g[k0 + kk]; scr[kk * 33 + (lane & 31)] = v; }
    LDS_WAIT(); asm volatile("" ::: "memory");
    const int c = lane & 7;
#pragma unroll
    for (int j = 0; j < 4; ++j) { const int n = (lane >> 3) + 8 * j; const LAS float* s = scr + (8 * c) * 33 + n;
        u32x4 o; o.x = pk2(s[0 * 33], s[1 * 33]); o.y = pk2(s[2 * 33], s[3 * 33]); o.z = pk2(s[4 * 33], s[5 * 33]); o.w = pk2(s[6 * 33], s[7 * 33]);
        *(GAS u32x4*)(WT + (size_t)(dst_row0 + n) * K + k0 + 8 * c) = o; }
    LDS_WAIT(); asm volatile("" ::: "memory");
}

typedef unsigned short us4 __attribute__((ext_vector_type(4)));
constexpr int P2_ROWB = 272;

__device__ __forceinline__ void p2_daxis_unit(LAS unsigned char* lds, const bf16_t* Abuf, const bf16_t* CWT, bf16_t* Pt, int b, int sblk, int h, int tid) {
    const int wid = tid >> 6, lane = tid & 63, fr = lane & 15, fq = lane >> 4;
    const bf16_t* cw = CWT + (size_t)h * 256 * 128;
#pragma unroll
    for (int i = 0; i < 8; ++i) { const int piece = tid + i * NTHR, r = piece >> 4, c = piece & 15; const u32x4 v = *(const GAS u32x4*)(cw + r * 128 + c * 8); *(LAS u32x4*)(lds + r * P2_ROWB + c * 16) = v; }
    const int tok0 = b * SEQ + sblk * 128;
    bf16x8 af[4];
#pragma unroll
    for (int ks = 0; ks < 4; ++ks) af[ks] = *(const GAS bf16x8*)(Abuf + (size_t)(tok0 + 16 * wid + fr) * FW + h * 128 + ks * 32 + fq * 8);
    LDS_WAIT(); __syncthreads();
#pragma unroll 4
    for (int nt = 0; nt < 16; ++nt) {
        f32x4 acc = {0.f, 0.f, 0.f, 0.f};
#pragma unroll
        for (int ks = 0; ks < 4; ++ks) { const bf16x8 bfr = *(const LAS bf16x8*)(lds + (16 * nt + fr) * P2_ROWB + ks * 64 + fq * 16); acc = __builtin_amdgcn_mfma_f32_16x16x32_bf16(af[ks], bfr, acc, 0, 0, 0); }
        const int ep = 16 * nt + fr; const int prow = b * 1024 + h * 128 + (ep & 127); const int kk0 = (ep >> 7) * SEQ + sblk * 128 + 16 * wid + 4 * fq;
        u32x2 w; w.x = pg8::cvt_pk_bf16(acc[0], acc[1]); w.y = pg8::cvt_pk_bf16(acc[2], acc[3]);
        *(GAS u32x2*)(Pt + (size_t)prow * KDFT + kk0) = w;
    }
    __syncthreads();
}

__device__ __forceinline__ void p2_spatial_unit(LAS unsigned char* lds, const bf16_t* VT, const bf16_t* Ubuf, const float* wsp, const float* bsp, const float* gsgu, bf16_t* Ycat, int b, int n, int h, int tid) {
    const int wid = tid >> 6, lane = tid & 63, fr = lane & 15, fq = lane >> 4;
    LAS float* red = (LAS float*)(lds + 40960);
    LAS float* rstdv = (LAS float*)(lds + 40960 + 4096);
    const int tok0 = b * SEQ + n * 128;
    {
        float s0 = 0.f, s1 = 0.f;
        const bf16_t* p = VT + (size_t)(128 * wid) * MTOK + tok0 + 2 * lane;
#pragma unroll 8
        for (int f = 0; f < 128; ++f) { const unsigned w = *(const GAS unsigned*)(p + (size_t)f * MTOK); const float a = bf2f((unsigned short)(w & 0xffffu)), c = bf2f((unsigned short)(w >> 16)); s0 += a * a; s1 += c * c; }
        red[wid * 128 + 2 * lane] = s0; red[wid * 128 + 2 * lane + 1] = s1;
    }
    bf16x8 af[4];
#pragma unroll
    for (int ks = 0; ks < 4; ++ks) af[ks] = *(const GAS bf16x8*)(VT + (size_t)(h * 128 + 16 * wid + fr) * MTOK + tok0 + ks * 32 + fq * 8);
    LDS_WAIT(); __syncthreads();
    if (tid < 128) { float s = 0.f;
#pragma unroll
        for (int w = 0; w < 8; ++w) s += red[w * 128 + tid];
        rstdv[tid] = 1.0f / sqrtf(s * (1.0f / 1024.0f) + EPS); }
    LDS_WAIT(); __syncthreads();
    const float* wh = wsp + (size_t)h * 128 * 128;
#pragma unroll
    for (int i = 0; i < 8; ++i) { const int piece = tid + i * NTHR, r = piece >> 5, c4 = (piece & 31) * 4; const f32x4 v = *(const GAS f32x4*)(wh + r * 128 + c4); const f32x4 rs = *(const LAS f32x4*)(rstdv + c4);
        u32x2 w; w.x = pk2(v[0] * rs[0], v[1] * rs[1]); w.y = pk2(v[2] * rs[2], v[3] * rs[3]); *(LAS u32x2*)(lds + r * P2_ROWB + c4 * 2) = w; }
    LDS_WAIT(); __syncthreads();
    const int d0 = 16 * wid + 4 * fq;
    const f32x4 gv = *(const GAS f32x4*)(gsgu + h * 128 + d0);
#pragma unroll 4
    for (int nt = 0; nt < 8; ++nt) {
        f32x4 acc = {0.f, 0.f, 0.f, 0.f};
#pragma unroll
        for (int ks = 0; ks < 4; ++ks) { const bf16x8 bfr = *(const LAS bf16x8*)(lds + (16 * nt + fr) * P2_ROWB + ks * 64 + fq * 16); acc = __builtin_amdgcn_mfma_f32_16x16x32_bf16(af[ks], bfr, acc, 0, 0, 0); }
        const int p = 16 * nt + fr; const float bias = bsp[h * 128 + p];
        const u32x2 uw = *(const GAS u32x2*)(Ubuf + (size_t)(tok0 + p) * GW + h * 128 + d0);
        const float u0 = bf2f((unsigned short)(uw.x & 0xffffu)), u1 = bf2f((unsigned short)(uw.x >> 16)), u2 = bf2f((unsigned short)(uw.y & 0xffffu)), u3 = bf2f((unsigned short)(uw.y >> 16));
        u32x2 w; w.x = pg8::cvt_pk_bf16(u0 * (gv[0] * acc[0] + bias), u1 * (gv[1] * acc[1] + bias)); w.y = pg8::cvt_pk_bf16(u2 * (gv[2] * acc[2] + bias), u3 * (gv[3] * acc[3] + bias));
        *(GAS u32x2*)(Ycat + (size_t)(tok0 + p) * DM + FW + h * 128 + d0) = w;
    }
    __syncthreads();
}

__global__ void __launch_bounds__(NTHR, 2) mk_fwd(Args args) {
    extern __shared__ __attribute__((aligned(16))) unsigned char lds_raw[];
    LAS unsigned char* lds = (LAS unsigned char*)lds_raw;
    volatile LAS unsigned* MISC = (volatile LAS unsigned*)(lds + MISC_OFF);
    const int tid = threadIdx.x, lane = tid & 63, wave = __builtin_amdgcn_readfirstlane(tid >> 6);
    const int G = gridDim.x; const int bx = blockIdx.x; const int vcu = (G % 8 == 0) ? (bx % 8) * (G / 8) + bx / 8 : bx;
    unsigned char* ws = args.ws;
    gu32* ctl = (gu32*)(ws + WS_CTL);
    const float* x = args.in[0]; const float* norm_mix = args.in[1]; const float* w_in = args.in[2]; const float* w_fourier = args.in[3]; const float* sgu_norm = args.in[4];
    const float* w_spatial = args.in[5]; const float* b_spatial = args.in[6]; const float* w_out = args.in[7]; const float* norm_ffn = args.in[8];
    const float* w_gate = args.in[9]; const float* w_up = args.in[10]; const float* w_down = args.in[11]; const float* norm_final = args.in[12];
    float* out = args.out;
    bf16_t* Wgu = (bf16_t*)(ws + WS_WGU); bf16_t* Wd = (bf16_t*)(ws + WS_WD); bf16_t* Wout = (bf16_t*)(ws + WS_WOUT); bf16_t* Adft = (bf16_t*)(ws + WS_ADFT);
    bf16_t* Abuf = (bf16_t*)(ws + WS_A); bf16_t* Ubuf = (bf16_t*)(ws + WS_U); bf16_t* VT = (bf16_t*)(ws + WS_VT); bf16_t* XB = (bf16_t*)(ws + WS_XB); bf16_t* Pt = (bf16_t*)(ws + WS_PT);
    bf16_t* Win = (bf16_t*)(ws + WS_WIN); bf16_t* Ycat = (bf16_t*)(ws + WS_YCAT); bf16_t* X1B = (bf16_t*)(ws + WS_X1B); bf16_t* Hb = (bf16_t*)(ws + WS_H);
    float* rstd1 = (float*)(ws + WS_RSTD1); float* ss1 = (float*)(ws + WS_SS1); float* ss2 = (float*)(ws + WS_SS2); bf16_t* CWT = (bf16_t*)(ws + WS_CWT);

    for (int u = tid; u < (TAB_OFF - LDSCTL_OFF) / 4; u += NTHR) ((LAS unsigned*)(lds + LDSCTL_OFF))[u] = 0u;
    __syncthreads();
    XcdBarrier bar; bar.bar = (unsigned*)(ctl + CW_BAR); bar.x = 0; bar.st = nullptr;
    if (!MK_PER_PHASE) bar = xcd_barrier_post((unsigned*)(ctl + CW_BAR), MISC + 8);
    const int lo = args.ph_lo, hi = args.ph_hi;
#define IN(k) (lo <= (k) && (k) < hi)
#define SEAM(k) do { if (IN(k) && IN((k) + 1)) xcd_barrier(bar); } while (0)

    if (IN(0)) {
        LAS float* tab = (LAS float*)(lds + TAB_OFF);
        for (int i = tid; i < 4096; i += NTHR) tab[i] = cospif((float)i * (1.0f / 2048.0f));
        __syncthreads();
        LAS float* scr = (LAS float*)(lds + RING_OFF + wave * 16384);
        const int gw = vcu * NWAVES + wave, NGW = G * NWAVES;
        for (int m = gw; m < MTOK; m += NGW) {
            const GAS f32x4* xr = (const GAS f32x4*)(x + (size_t)m * DM) + lane; f32x4 v[8]; float s = 0.f;
#pragma unroll
            for (int j = 0; j < 8; ++j) { v[j] = xr[64 * j]; s += (v[j].x * v[j].x + v[j].y * v[j].y) + (v[j].z * v[j].z + v[j].w * v[j].w); }
            s = wave_sum(s);
            if (lane == 0) rstd1[m] = 1.0f / sqrtf(s * (1.0f / DM) + EPS);
            GAS unsigned long long* o8 = (GAS unsigned long long*)(XB + (size_t)m * DM) + lane;
#pragma unroll
            for (int j = 0; j < 8; ++j) o8[64 * j] = (unsigned long long)pk2(v[j].x, v[j].y) | ((unsigned long long)pk2(v[j].z, v[j].w) << 32);
        }
        constexpr int I_IN = (DM / 64) * (INW / 32), I_OUT = (DM / 64) * (DM / 32), I_G = (DM / 64) * (DFF / 32), I_D = (DFF / 64) * (DM / 32);
        constexpr int NITEMS = I_IN + I_OUT + 2 * I_G + I_D;
        for (int it = gw; it < NITEMS; it += NGW) {
            int r = it;
            if (r < I_IN) { const int nb = INW / 32, kb = r / nb, n0 = 32 * (r % nb); p0_transpose_item(w_in, DM, INW, Win, norm_mix, scr, 64 * kb, n0, n0, lane); continue; } r -= I_IN;
            if (r < I_OUT) { const int nb = DM / 32, kb = r / nb, n0 = 32 * (r % nb); p0_transpose_item(w_out, DM, DM, Wout, nullptr, scr, 64 * kb, n0, n0, lane); continue; } r -= I_OUT;
            if (r < I_G) { const int nb = DFF / 32, kb = r / nb, n0 = 32 * (r % nb); p0_transpose_item(w_gate, DM, DFF, Wgu, norm_ffn, scr, 64 * kb, n0, (n0 >> 7) * 256 + (n0 & 127), lane); continue; } r -= I_G;
            if (r < I_G) { const int nb = DFF / 32, kb = r / nb, n0 = 32 * (r % nb); p0_transpose_item(w_up, DM, DFF, Wgu, norm_ffn, scr, 64 * kb, n0, (n0 >> 7) * 256 + 128 + (n0 & 127), lane); continue; } r -= I_G;
            { const int nb = DM / 32, kb = r / nb, n0 = 32 * (r % nb); p0_transpose_item(w_down, DFF, DM, Wd, nullptr, scr, 64 * kb, n0, n0, lane); }
        }
        for (int k = gw; k < SEQ; k += NGW) {
            GAS u32x4* orow = (GAS u32x4*)(Adft + (size_t)k * KDFT);
#pragma unroll 2
            for (int it = 0; it < 16; ++it) { const int kk = (it * 64 + lane) * 8; const int s0 = kk & 4095; const int ph = (kk >> 12) * 1024; float v[8];
#pragma unroll
                for (int j = 0; j < 8; ++j) v[j] = tab[(k * (s0 + j) + ph) & 4095] * (1.0f / 64.0f);
                u32x4 o; o.x = pk2(v[0], v[1]); o.y = pk2(v[2], v[3]); o.z = pk2(v[4], v[5]); o.w = pk2(v[6], v[7]); orow[it * 64 + lane] = o; }
        }
        for (int it = gw; it < 8 * 256; it += NGW) {
            const int h = it >> 8, ep = it & 255, e = ep & 127, ph = (ep >> 7) * 3072;
            const float* wf = w_fourier + (size_t)h * 16384 + e; float a0 = 0.f, a1 = 0.f;
#pragma unroll 4
            for (int j = 0; j < 128; ++j) { const float w = wf[j * 128]; a0 += tab[(((lane * j) & 127) * 32 + ph) & 4095] * w; a1 += tab[((((lane + 64) * j) & 127) * 32 + ph) & 4095] * w; }
            bf16_t* o = CWT + (size_t)it * 128; o[lane] = (bf16_t)f2bf(a0 * 0.08838834764831845f); o[lane + 64] = (bf16_t)f2bf(a1 * 0.08838834764831845f);
        }
    }
    SEAM(0);

    if (IN(1)) {
        pg8::Order S; S.init(MTOK, INW, DM, G, bx, XB, Win, 8);
        pg8::EpiIn E{Abuf, Ubuf, VT, rstd1};
        pg8::gemm_phase<pg8::EpiIn, pg8::Order, true, true>(lds + RING_OFF, DM, S, E);
    }
    SEAM(1);

    if (IN(2)) {
        for (int i = 0; i < 2; ++i) { const int j = vcu * 2 + i; if (j < 512) { const int h = j & 7, bn = j >> 3; p2_spatial_unit(lds, VT, Ubuf, w_spatial, b_spatial, sgu_norm, Ycat, bn >> 5, bn & 31, h, tid); } }
        for (int i = 0; i < 2; ++i) { const int j = vcu * 2 + i; if (j < 512) { const int h = j & 7, bs = j >> 3; p2_daxis_unit(lds, Abuf, CWT, Pt, bs >> 5, bs & 31, h, tid); } }
        if (G != 256) { for (int j = 2 * G + vcu; j < 512; j += G) { const int h = j & 7, bn = j >> 3; p2_spatial_unit(lds, VT, Ubuf, w_spatial, b_spatial, sgu_norm, Ycat, bn >> 5, bn & 31, h, tid); p2_daxis_unit(lds, Abuf, CWT, Pt, bn >> 5, bn & 31, h, tid); } }
    }
    SEAM(2);

    if (IN(3)) {
        pg8::Order S; S.init(SEQ, 2048, KDFT, G, bx, Adft, Pt);
        pg8::EpiDft E{Ycat};
        pg8::gemm_phase<pg8::EpiDft, pg8::Order, true, true>(lds + RING_OFF, KDFT, S, E);
    }
    SEAM(3);

    if (IN(4)) {
        pg8::Order S; S.init(MTOK, DM, DM, G, bx, Ycat, Wout);
        pg8::EpiRes<true> E{x, out, X1B, ss1};
        pg8::gemm_phase<pg8::EpiRes<true>, pg8::Order, false, true>(lds + RING_OFF, DM, S, E);
    }
    SEAM(4);

    if (IN(5)) {
        pg8::Order S; S.init(MTOK, NGU, DM, G, bx, X1B, Wgu);
        pg8::EpiGU E{Hb, ss1};
        pg8::gemm_phase<pg8::EpiGU, pg8::Order, true, true>(lds + RING_OFF, DM, S, E);
    }
    SEAM(5);

    if (IN(6)) {
        pg8::Order S; S.init(MTOK, DM, DFF, G, bx, Hb, Wd);
        pg8::EpiRes<false> E{out, out, nullptr, ss2};
        pg8::gemm_phase<pg8::EpiRes<false>, pg8::Order, false, true>(lds + RING_OFF, DFF, S, E);
    }
    SEAM(6);

    if (IN(7)) {
        const int gw = vcu * NWAVES + wave, NGW = G * NWAVES;
        f32x4 gf[8];
#pragma unroll
        for (int j = 0; j < 8; ++j) gf[j] = ((const GAS f32x4*)norm_final)[lane + 64 * j];
        for (int m = gw; m < MTOK; m += NGW) {
            const f32x4 p0 = *(const GAS f32x4*)(ss2 + (size_t)m * 8), p1 = *(const GAS f32x4*)(ss2 + (size_t)m * 8 + 4);
            const float ss = ((p0[0] + p0[1]) + (p0[2] + p0[3])) + ((p1[0] + p1[1]) + (p1[2] + p1[3]));
            const float r = 1.0f / sqrtf(ss * (1.0f / DM) + EPS);
            GAS f32x4* xr = (GAS f32x4*)(out + (size_t)m * DM) + lane;
#pragma unroll
            for (int j = 0; j < 8; ++j) { const f32x4 v = xr[64 * j]; xr[64 * j] = v * r * gf[j]; }
        }
    }
#undef IN
#undef SEAM
}

static void launch(hipStream_t stream, void* const* d_in, void* d_out, void* d_ws) {
    static int grid = 0;
    if (grid == 0) {
        int dev = 0, cus = 0;
        if (hipGetDevice(&dev) != hipSuccess || hipDeviceGetAttribute(&cus, hipDeviceAttributeMultiprocessorCount, dev) != hipSuccess) { fprintf(stderr, "kernel_launch: device query failed\n"); grid = -1; return; }
        if (hipFuncSetAttribute((const void*)mk_fwd, hipFuncAttributeMaxDynamicSharedMemorySize, LDS_BYTES) != hipSuccess) { fprintf(stderr, "kernel_launch: hipFuncSetAttribute failed\n"); grid = -1; return; }
        int per_cu = 0;
        if (hipOccupancyMaxActiveBlocksPerMultiprocessor(&per_cu, (const void*)mk_fwd, NTHR, LDS_BYTES) != hipSuccess || per_cu < 1) fprintf(stderr, "kernel_launch: occupancy query reports %d workgroups per CU\n", per_cu);
        (void)hipGetLastError();
        grid = cus;
        if (grid != 256) fprintf(stderr, "kernel_launch: %d CUs; this kernel is laid out for 256 (the one-unit-per-workgroup phases need exactly 256 workgroups)\n", grid);
        grid = 256;
    }
    if (grid < 0) return;
    if (hipMemsetAsync((char*)d_ws + WS_CTL, 0, CTL_ZERO_BYTES, stream) != hipSuccess) { fprintf(stderr, "kernel_launch: memset failed\n"); return; }
    Args a{};
    for (int i = 0; i < 13; ++i) a.in[i] = (const float*)d_in[i];
    a.out = (float*)d_out; a.ws = (unsigned char*)d_ws;
#if MK_PER_PHASE
    for (int p = 0; p < NPHASE; ++p) { a.ph_lo = p; a.ph_hi = p + 1; hipLaunchKernelGGL(mk_fwd, dim3(grid), dim3(NTHR), LDS_BYTES, stream, a); }
#else
    a.ph_lo = 0; a.ph_hi = NPHASE; hipLaunchKernelGGL(mk_fwd, dim3(grid), dim3(NTHR), LDS_BYTES, stream, a);
#endif
    const hipError_t le = hipPeekAtLastError();
    if (le != hipSuccess) fprintf(stderr, "kernel_launch: launch failed: %s\n", hipGetErrorName(le));
}
}
extern "C" void kernel_launch(void* const* d_in, const int* in_sizes, int n_in, void* d_out, int out_size, void* d_ws, size_t ws_size, hipStream_t stream) {
    (void)in_sizes; (void)n_in; (void)out_size; (void)ws_size;
    fp::launch(stream, d_in, d_out, d_ws);
}
```

```cpp
#include <hip/hip_runtime.h>
#include <cstdio>
#include <cstdint>
namespace pg8 {
#define PG8_LAS __attribute__((address_space(3)))
typedef unsigned short bf16_t;
typedef short bf16x8 __attribute__((ext_vector_type(8)));
typedef float f32x4 __attribute__((ext_vector_type(4)));
typedef float f32x2 __attribute__((ext_vector_type(2)));
typedef unsigned u32x4 __attribute__((ext_vector_type(4)));
typedef unsigned u32x2 __attribute__((ext_vector_type(2)));
constexpr int BM = 256, BK = 64, HALF = 128, HTB = HALF * BK * 2  , STAGE_BYTES = 8 * HTB, NXCD = 8, WGM = 8;

__host__ __device__ __forceinline__ int lds_byte(int r, int c) { const int st = (r >> 4) * 2 + (c >> 5), rr = r & 15, cc = c & 31, ob = rr * 64 + cc * 2; return st * 1024 + (ob ^ (((ob >> 9) & 1) << 5)); }
__host__ __device__ __forceinline__ void stage_rc(int b, int& R, int& C) { const int st = b / 1024, sb = b % 1024, swz = sb ^ (((sb >> 9) & 1) << 5); R = (st >> 1) * 16 + swz / 64; C = (st & 1) * 32 + (swz % 64) / 2; }
__host__ __device__ __forceinline__ int perm32(int rho) { const int n = rho >> 4, i = rho & 15; return 8 * (i >> 2) + 4 * n + (i & 3); }

struct Unit { int pm, pn; };

struct Order {
    int nM, nN, nwg, G, c; const char* A; const char* B; size_t tstep; int swap_from;
    __device__ void init(int M, int N, int K, int G_, int c_, const void* A_, const void* B_, int swap_from_ = 1 << 30) { nM = M / BM; nN = N / BM; nwg = nM * nN; G = G_; c = c_; A = (const char*)A_; B = (const char*)B_; tstep = (size_t)BM * K * 2; swap_from = swap_from_; }
    __device__ bool next(int i, Unit& u) const {
        const long L = (long)i * G + c; if (L >= nwg) return false;
        int wgid = (int)L; { const int q = nwg / NXCD, r = nwg % NXCD, xcd = wgid % NXCD, off = wgid / NXCD; wgid = (xcd < r ? xcd * (q + 1) : r * (q + 1) + (xcd - r) * q) + off; }
        const int nig = WGM * nN, gid = wgid / nig, fm = gid * WGM, gsz = (nM - fm) < WGM ? (nM - fm) : WGM;
        u.pm = fm + ((wgid % nig) % gsz); u.pn = (wgid % nig) / gsz; return true;
    }
    __device__ __forceinline__ const char* aptr(const Unit& u) const { return u.pn >= swap_from ? B + (size_t)u.pn * tstep : A + (size_t)u.pm * tstep; }
    __device__ __forceinline__ const char* bptr(const Unit& u) const { return u.pn >= swap_from ? A + (size_t)u.pm * tstep : B + (size_t)u.pn * tstep; }
    __device__ __forceinline__ void a_ready(const Unit&) const {}
    __device__ __forceinline__ void done(const Unit&) const {}
};

typedef __bf16 bf16x2_t __attribute__((ext_vector_type(2)));
__device__ __forceinline__ unsigned cvt_pk_bf16(float lo, float hi) { f32x2 v = {lo, hi}; bf16x2_t b = __builtin_convertvector(v, bf16x2_t); return __builtin_bit_cast(unsigned, b); }
__device__ __forceinline__ u32x4 pack8(const f32x4 v0, const f32x4 v1) { u32x4 w; w.x = cvt_pk_bf16(v0[0], v0[1]); w.y = cvt_pk_bf16(v0[2], v0[3]); w.z = cvt_pk_bf16(v1[0], v1[1]); w.w = cvt_pk_bf16(v1[2], v1[3]); return w; }
__device__ __forceinline__ float gelu_t(float x) { const float u = x * (0.7978845608f + 0.0356774081f * x * x); return x * __builtin_amdgcn_rcpf(1.0f + __builtin_amdgcn_exp2f(-2.8853900818f * u)); }
__device__ __forceinline__ f32x4 gelu4(f32x4 v) { return (f32x4){gelu_t(v[0]), gelu_t(v[1]), gelu_t(v[2]), gelu_t(v[3])}; }
__device__ __forceinline__ float silu_f(float x) { return x * __builtin_amdgcn_rcpf(1.0f + __builtin_amdgcn_exp2f(-1.4426950409f * x)); }


struct EpiIn {
    static constexpr bool PERM = true, AFTER_DRAIN = false;
    bf16_t* Abuf; bf16_t* Ubuf; bf16_t* VT; const float* rstd1;
    __device__ __forceinline__ void operator()(const f32x4 (&acc)[2][2][4][2], const Unit& u, int wr, int wc, int fr, int fq) const {
        const int kind = u.pn >> 2;
        if (kind < 2) {
            bf16_t* base = kind == 0 ? Abuf : Ubuf;
            const int row0 = u.pm * BM + wr * 64 + fr, col0 = (u.pn & 3) * BM + wc * 32 + 8 * fq;
#pragma unroll
            for (int ai = 0; ai < 2; ++ai)
#pragma unroll
                for (int m = 0; m < 4; ++m) { const int row = row0 + ai * HALF + m * 16; const float rs = rstd1[row]; bf16_t* rowp = base + (size_t)row * 1024 + col0;
#pragma unroll
                    for (int bj = 0; bj < 2; ++bj) { f32x4 v0 = acc[ai][bj][m][0] * rs, v1 = acc[ai][bj][m][1] * rs;
                        if (kind == 1) { v0 = gelu4(v0); v1 = gelu4(v1); }
                        *(u32x4*)(rowp + bj * HALF) = pack8(v0, v1); } }
        } else {
            const int f0 = (u.pn - 8) * BM + wr * 64 + fr, t0 = u.pm * BM + wc * 32 + 8 * fq;
            f32x4 rs[2][2];
#pragma unroll
            for (int bj = 0; bj < 2; ++bj) { rs[bj][0] = *(const f32x4*)(rstd1 + t0 + bj * HALF); rs[bj][1] = *(const f32x4*)(rstd1 + t0 + bj * HALF + 4); }
#pragma unroll
            for (int ai = 0; ai < 2; ++ai)
#pragma unroll
                for (int m = 0; m < 4; ++m) { bf16_t* rowp = VT + (size_t)(f0 + ai * HALF + m * 16) * 8192 + t0;
#pragma unroll
                    for (int bj = 0; bj < 2; ++bj) { const f32x4 v0 = gelu4(acc[ai][bj][m][0] * rs[bj][0]), v1 = gelu4(acc[ai][bj][m][1] * rs[bj][1]);
                        *(u32x4*)(rowp + bj * HALF) = pack8(v0, v1); } }
        }
    }
};
struct EpiDft {
    static constexpr bool PERM = true, AFTER_DRAIN = false;
    bf16_t* Ycat;
    __device__ __forceinline__ void operator()(const f32x4 (&acc)[2][2][4][2], const Unit& u, int wr, int wc, int fr, int fq) const {
        const int row0 = (u.pn >> 2) * 4096 + u.pm * BM + wr * 64 + fr, col0 = (u.pn & 3) * BM + wc * 32 + 8 * fq;
#pragma unroll
        for (int ai = 0; ai < 2; ++ai)
#pragma unroll
            for (int m = 0; m < 4; ++m) { bf16_t* rowp = Ycat + (size_t)(row0 + ai * HALF + m * 16) * 2048 + col0;
#pragma unroll
                for (int bj = 0; bj < 2; ++bj) *(u32x4*)(rowp + bj * HALF) = pack8(acc[ai][bj][m][0], acc[ai][bj][m][1]); }
    }
};
struct EpiGU {
    static constexpr bool PERM = true, AFTER_DRAIN = false;
    bf16_t* Hb; const float* ss1;
    __device__ __forceinline__ void operator()(const f32x4 (&acc)[2][2][4][2], const Unit& u, int wr, int wc, int fr, int fq) const {
        const int row0 = u.pm * BM + wr * 64 + fr, col0 = u.pn * HALF + wc * 32 + 8 * fq;
#pragma unroll
        for (int ai = 0; ai < 2; ++ai)
#pragma unroll
            for (int m = 0; m < 4; ++m) { const int row = row0 + ai * HALF + m * 16;
                const f32x4 p0 = *(const f32x4*)(ss1 + (size_t)row * 8), p1 = *(const f32x4*)(ss1 + (size_t)row * 8 + 4);
                const float ss = ((p0[0] + p0[1]) + (p0[2] + p0[3])) + ((p1[0] + p1[1]) + (p1[2] + p1[3]));
                const float r = 1.0f / sqrtf(ss * (1.0f / 2048.0f) + 1e-6f);
                f32x4 h0, h1;
#pragma unroll
                for (int j = 0; j < 4; ++j) { h0[j] = silu_f(acc[ai][0][m][0][j] * r) * (acc[ai][1][m][0][j] * r); h1[j] = silu_f(acc[ai][0][m][1][j] * r) * (acc[ai][1][m][1][j] * r); }
                *(u32x4*)(Hb + (size_t)row * 5632 + col0) = pack8(h0, h1); }
    }
};
template <bool WRITE_BF16> struct EpiRes {
    static constexpr bool PERM = true, AFTER_DRAIN = true;
    const float* base; float* out; bf16_t* outb; float* ssp; int skip;
    __device__ __forceinline__ void fused(f32x4 (&acc)[2][2][4][2], const Unit& u, int wr, int wc, int fr, int fq, PG8_LAS unsigned char* lds, int wid, int lane) const {
        if (skip) { asm volatile("" :: "v"(acc[0][0][0][0]), "v"(acc[1][1][3][1])); return; }
        PG8_LAS float* P = (PG8_LAS float*)lds;
        const int col0 = u.pn * BM + wc * 32 + 8 * fq;
#pragma unroll
        for (int ai = 0; ai < 2; ++ai)
#pragma unroll
            for (int m = 0; m < 4; ++m) { const int rl = ai * HALF + wr * 64 + m * 16 + fr; const size_t off = (size_t)(u.pm * BM + rl) * 2048 + col0; float ss = 0.f;
#pragma unroll
                for (int bj = 0; bj < 2; ++bj) { const f32x4 b0 = *(const f32x4*)(base + off + bj * HALF), b1 = *(const f32x4*)(base + off + bj * HALF + 4);
                    const f32x4 v0 = b0 + acc[ai][bj][m][0], v1 = b1 + acc[ai][bj][m][1];
                    *(f32x4*)(out + off + bj * HALF) = v0; *(f32x4*)(out + off + bj * HALF + 4) = v1;
                    if (WRITE_BF16) *(u32x4*)(outb + off + bj * HALF) = pack8(v0, v1);
                    ss += ((v0[0] * v0[0] + v0[1] * v0[1]) + (v0[2] * v0[2] + v0[3] * v0[3])) + ((v1[0] * v1[0] + v1[1] * v1[1]) + (v1[2] * v1[2] + v1[3] * v1[3])); }
                ss += __shfl_xor(ss, 16); ss += __shfl_xor(ss, 32);
                if (fq == 0) P[rl * 4 + wc] = ss;
                asm volatile("" ::: "memory"); }
        asm volatile("s_waitcnt lgkmcnt(0)" ::: "memory"); __builtin_amdgcn_s_barrier(); asm volatile("" ::: "memory");
        const int tid = wid * 64 + lane;
        if (tid < 256) { const f32x4 p = *(const PG8_LAS f32x4*)(P + tid * 4); ssp[(size_t)(u.pm * BM + tid) * 8 + u.pn] = (p[0] + p[1]) + (p[2] + p[3]); }
    }
};

template <class Epi, class Sched, bool ALIGN_EPI = false, bool SP2 = false>
__device__ __forceinline__ void gemm_phase(PG8_LAS unsigned char* lds, const int K, const Sched& S, const Epi& E) {
    const int tid = threadIdx.x, wid = __builtin_amdgcn_readfirstlane(tid >> 6), lane = tid & 63, wr = wid >> 2, wc = wid & 3, fr = lane & 15, fq = lane >> 4;
    const int nt = K / BK;
    unsigned voffA[2], voffB[2];
#pragma unroll
    for (int i = 0; i < 2; ++i) { int R, C; stage_rc(tid * 16 + i * 8192, R, C); const int Rb = Epi::PERM ? ((R & ~31) + perm32(R & 31)) : R;
        voffA[i] = (unsigned)(R * K + C) * 2u; voffB[i] = (unsigned)(Rb * K + C) * 2u; }
    const size_t kstep = (size_t)(BK * 2);
    const size_t hstep = (size_t)HALF * K * 2;
    const unsigned ldsw = (unsigned)wid * 1024u;
    const int aoff = lds_byte(wr * 64 + fr, fq * 8), boff = lds_byte(wc * 32 + fr, fq * 8);
#define PG8_SA(b, h) (((b) * 2 + (h)) * HTB)
#define PG8_SB(b, h) ((4 + (b) * 2 + (h)) * HTB)
#define PG8_STAGE(bufoff, gbase, voff) do { _Pragma("unroll") for (int _i = 0; _i < 2; ++_i) \
        __builtin_amdgcn_global_load_lds((const unsigned*)((const char*)(gbase) + (voff)[_i]), (PG8_LAS unsigned*)(lds + (bufoff) + ldsw + _i * 8192), 16, 0, 0); } while (0)
#define PG8_LDA(dst, b, h) do { _Pragma("unroll") for (int m = 0; m < 4; ++m) _Pragma("unroll") for (int k = 0; k < 2; ++k) dst[m][k] = *(const PG8_LAS bf16x8*)(lds + PG8_SA(b, h) + aoff + m * 2048 + k * 1024); } while (0)
#define PG8_LDB(dst, b, h) do { _Pragma("unroll") for (int n = 0; n < 2; ++n) _Pragma("unroll") for (int k = 0; k < 2; ++k) dst[n][k] = *(const PG8_LAS bf16x8*)(lds + PG8_SB(b, h) + boff + n * 2048 + k * 1024); } while (0)
#define PG8_MMA(ai, bj, At, Bt) do { __builtin_amdgcn_s_setprio(1); _Pragma("unroll") for (int m = 0; m < 4; ++m) _Pragma("unroll") for (int n = 0; n < 2; ++n) _Pragma("unroll") for (int k = 0; k < 2; ++k) \
        acc[ai][bj][m][n] = __builtin_amdgcn_mfma_f32_16x16x32_bf16(Bt[n][k], At[m][k], acc[ai][bj][m][n], 0, 0, 0); __builtin_amdgcn_s_setprio(0); } while (0)
#define PG8_WAIT_V(n) asm volatile("s_waitcnt vmcnt(" #n ")" ::: "memory")
#define PG8_WAIT_L(n) asm volatile("s_waitcnt lgkmcnt(" #n ")" ::: "memory")
#define PG8_BAR __builtin_amdgcn_s_barrier()
#define PG8_SCHED __builtin_amdgcn_sched_barrier(0)
    Unit cur, nxt; int ui = 0;
    if (!S.next(0, cur)) return;
    f32x4 acc[2][2][4][2];
#pragma unroll
    for (int a = 0; a < 2; ++a)
#pragma unroll
        for (int b = 0; b < 2; ++b)
#pragma unroll
            for (int m = 0; m < 4; ++m)
#pragma unroll
                for (int n = 0; n < 2; ++n) acc[a][b][m][n] = (f32x4){0.f, 0.f, 0.f, 0.f};
    bf16x8 At[4][2], B0[2][2], B1[2][2];
    const char* cA = S.aptr(cur); const char* cB = S.bptr(cur);
    S.a_ready(cur);
    if constexpr (SP2) {
        PG8_STAGE(PG8_SB(0, 0), cB, voffB); PG8_STAGE(PG8_SB(0, 1), cB + hstep, voffB); PG8_STAGE(PG8_SA(0, 0), cA, voffA); PG8_STAGE(PG8_SA(0, 1), cA + hstep, voffA);
        if (wr == 1) PG8_BAR;
        PG8_WAIT_V(2); PG8_BAR;
        PG8_STAGE(PG8_SB(1, 0), cB + kstep, voffB); PG8_STAGE(PG8_SA(1, 0), cA + kstep, voffA); PG8_STAGE(PG8_SB(1, 1), cB + hstep + kstep, voffB);
        PG8_WAIT_V(6); PG8_BAR;
    } else {
        PG8_STAGE(PG8_SB(0, 0), cB, voffB); PG8_STAGE(PG8_SA(0, 0), cA, voffA); PG8_STAGE(PG8_SB(0, 1), cB + hstep, voffB); PG8_STAGE(PG8_SA(0, 1), cA + hstep, voffA);
        if (wr == 1) PG8_BAR;
        PG8_WAIT_V(4); PG8_BAR;
        PG8_STAGE(PG8_SB(1, 0), cB + kstep, voffB); PG8_STAGE(PG8_SA(1, 0), cA + kstep, voffA); PG8_STAGE(PG8_SB(1, 1), cB + hstep + kstep, voffB);
        PG8_WAIT_V(6); PG8_BAR;
    }
    for (;;) {
        const bool has_next = Epi::AFTER_DRAIN ? false : S.next(ui + 1, nxt);
        const char* nA = has_next ? S.aptr(nxt) : cA; const char* nB = has_next ? S.bptr(nxt) : cB;
        for (int t = 0; t < nt; t += 2) {
            const bool last = (t == nt - 2);
            const char* a1 = cA + (size_t)(t + 1) * kstep;
            const char* a2 = last ? nA : cA + (size_t)(t + 2) * kstep; const char* b2 = last ? nB : cB + (size_t)(t + 2) * kstep;
            const char* a3 = a2 + kstep; const char* b3 = b2 + kstep;
            if (last && has_next) S.a_ready(nxt);
            if constexpr (SP2) {
            PG8_LDB(B0, 0, 0); PG8_LDB(B1, 0, 1); PG8_SCHED; PG8_LDA(At, 0, 0); PG8_STAGE(PG8_SA(1, 1), a1 + hstep, voffA);
            PG8_WAIT_V(8); PG8_WAIT_L(0); PG8_BAR; PG8_MMA(0, 0, At, B0); PG8_MMA(0, 1, At, B1); PG8_BAR; PG8_SCHED;
            PG8_LDA(At, 0, 1); PG8_STAGE(PG8_SB(0, 0), b2, voffB); PG8_STAGE(PG8_SB(0, 1), b2 + hstep, voffB); PG8_STAGE(PG8_SA(0, 0), a2, voffA);
            PG8_WAIT_V(8); PG8_WAIT_L(0); PG8_BAR; PG8_MMA(1, 0, At, B0); PG8_MMA(1, 1, At, B1); PG8_BAR; PG8_SCHED;
            PG8_LDB(B0, 1, 0); PG8_LDB(B1, 1, 1); PG8_SCHED; PG8_LDA(At, 1, 0); PG8_STAGE(PG8_SA(0, 1), a2 + hstep, voffA);
            PG8_WAIT_V(8); PG8_WAIT_L(0); PG8_BAR; PG8_MMA(0, 0, At, B0); PG8_MMA(0, 1, At, B1); PG8_BAR; PG8_SCHED;
            PG8_LDA(At, 1, 1); PG8_STAGE(PG8_SB(1, 0), b3, voffB); PG8_STAGE(PG8_SB(1, 1), b3 + hstep, voffB); PG8_STAGE(PG8_SA(1, 0), a3, voffA);
            PG8_WAIT_V(8); PG8_WAIT_L(0); PG8_BAR; PG8_MMA(1, 0, At, B0); PG8_MMA(1, 1, At, B1); PG8_BAR; PG8_SCHED;
            } else {
            PG8_LDB(B0, 0, 0); PG8_SCHED; PG8_LDA(At, 0, 0); PG8_STAGE(PG8_SA(1, 1), a1 + hstep, voffA);
            PG8_WAIT_L(8); PG8_BAR; PG8_WAIT_L(0); PG8_MMA(0, 0, At, B0); PG8_BAR; PG8_SCHED;
            PG8_LDB(B1, 0, 1); PG8_STAGE(PG8_SB(0, 0), b2, voffB);
            PG8_BAR; PG8_WAIT_L(0); PG8_MMA(0, 1, At, B1); PG8_BAR;
            PG8_LDA(At, 0, 1); PG8_STAGE(PG8_SA(0, 0), a2, voffA);
            PG8_BAR; PG8_WAIT_L(0); PG8_MMA(1, 0, At, B0); PG8_BAR; PG8_SCHED;
            PG8_STAGE(PG8_SB(0, 1), b2 + hstep, voffB);
            PG8_WAIT_V(6); PG8_BAR; PG8_MMA(1, 1, At, B1); PG8_BAR;
            PG8_LDB(B0, 1, 0); PG8_SCHED; PG8_LDA(At, 1, 0); PG8_STAGE(PG8_SA(0, 1), a2 + hstep, voffA);
            PG8_WAIT_L(8); PG8_BAR; PG8_WAIT_L(0); PG8_MMA(0, 0, At, B0); PG8_BAR; PG8_SCHED;
            PG8_LDB(B1, 1, 1); PG8_STAGE(PG8_SB(1, 0), b3, voffB);
            PG8_BAR; PG8_WAIT_L(0); PG8_MMA(0, 1, At, B1); PG8_BAR;
            PG8_LDA(At, 1, 1); PG8_STAGE(PG8_SA(1, 0), a3, voffA);
            PG8_BAR; PG8_WAIT_L(0); PG8_MMA(1, 0, At, B0); PG8_BAR; PG8_SCHED;
            PG8_STAGE(PG8_SB(1, 1), b3 + hstep, voffB);
            PG8_WAIT_V(6); PG8_BAR; PG8_MMA(1, 1, At, B1); PG8_BAR;
            }
        }
        if constexpr (ALIGN_EPI) { if (wr == 0) PG8_BAR; }
        if constexpr (!Epi::AFTER_DRAIN) { E(acc, cur, wr, wc, fr, fq); S.done(cur); }
        if (!has_next) break;
#pragma unroll
        for (int a = 0; a < 2; ++a)
#pragma unroll
            for (int b = 0; b < 2; ++b)
#pragma unroll
                for (int m = 0; m < 4; ++m)
#pragma unroll
                    for (int n = 0; n < 2; ++n) acc[a][b][m][n] = (f32x4){0.f, 0.f, 0.f, 0.f};
        cur = nxt; cA = nA; cB = nB; ++ui;
        if constexpr (ALIGN_EPI) { if (wr == 1) PG8_BAR; }
    }
    PG8_WAIT_V(0);
    if constexpr (!ALIGN_EPI) { if (wr == 0) PG8_BAR; }
    PG8_BAR;
    if constexpr (Epi::AFTER_DRAIN) { E.fused(acc, cur, wr, wc, fr, fq, lds, wid, lane); S.done(cur); }
#undef PG8_SA
#undef PG8_SB
#undef PG8_STAGE
#undef PG8_LDA
#undef PG8_LDB
#undef PG8_MMA
#undef PG8_WAIT_V
#undef PG8_WAIT_L
#undef PG8_BAR
#undef PG8_SCHED
}
}

namespace fp {
using pg8::bf16_t; using pg8::bf16x8; using pg8::f32x4; using pg8::u32x4; using pg8::u32x2;
constexpr int NWAVES = 8, NTHR = 512;
constexpr int SEQ = 4096, DM = 2048, MTOK = 8192, INW = 3072, FW = 1024, GW = 1024, DFF = 5632, NGU = 11264, KDFT = 8192;
constexpr float EPS = 1e-6f;
constexpr int NPHASE = 8;
#ifndef MK_P0MASK
#define MK_P0MASK 15
#endif
#ifndef MK_PROBE_SCALE
#define MK_PROBE_SCALE 1.0f
#endif
#ifndef MK_REPEAT
#define MK_REPEAT -1
#endif
#ifndef MK_PER_PHASE
#define MK_PER_PHASE 0
#endif

constexpr size_t MiB = 1u << 20;
constexpr size_t WS_CTL = 0, CTL_ZERO_BYTES = 64 * 1024;
constexpr size_t WS_WGU = 1 * MiB;
constexpr size_t WS_WD = 45 * MiB;
constexpr size_t WS_WOUT = 67 * MiB;
constexpr size_t WS_ADFT = 75 * MiB;
constexpr size_t WS_A = 139 * MiB;
constexpr size_t WS_U = 155 * MiB;
constexpr size_t WS_VT = 171 * MiB;
constexpr size_t WS_XB = 187 * MiB;
constexpr size_t WS_PT = 187 * MiB;
constexpr size_t WS_WIN = 219 * MiB;
constexpr size_t WS_YCAT = 219 * MiB;
constexpr size_t WS_SMALL = 251 * MiB;
constexpr size_t WS_RSTD1 = WS_SMALL;
constexpr size_t WS_SS1 = WS_SMALL + 64 * 1024;
constexpr size_t WS_SS2 = WS_SS1 + 256 * 1024;
constexpr size_t WS_CWT = WS_SMALL + 1 * MiB;
constexpr size_t WS_M1 = WS_CWT + 512 * 1024;
constexpr size_t WS_M3 = WS_M1 + 32 * 1024;
constexpr size_t WS_X1B = 187 * MiB;
constexpr size_t WS_H = 75 * MiB;
constexpr size_t WS_END = 256 * MiB;
static_assert(WS_WGU + (size_t)NGU * DM * 2 <= WS_WD && WS_WD + (size_t)DM * DFF * 2 <= WS_WOUT && WS_WOUT + (size_t)DM * DM * 2 <= WS_ADFT && WS_ADFT + (size_t)SEQ * KDFT * 2 <= WS_A, "ws map 1");
static_assert(WS_VT + (size_t)GW * MTOK * 2 <= WS_XB && WS_XB + (size_t)MTOK * DM * 2 <= WS_WIN && WS_YCAT + (size_t)MTOK * DM * 2 <= WS_SMALL && WS_M3 + 64 * 128 * 2 <= 253 * MiB, "ws map 2");
static_assert(WS_H + (size_t)MTOK * DFF * 2 <= WS_VT, "ws map 3");
constexpr int CW_BAR = 4096;

constexpr int RING_OFF = 0, RING_BYTES = 131072;
constexpr int LDSCTL_OFF = RING_BYTES, MISC_OFF = LDSCTL_OFF + 320;
constexpr int TAB_OFF = 135168;
constexpr int LDS_BYTES = 155648;
static_assert(TAB_OFF >= MISC_OFF + 128 && TAB_OFF + 16384 <= LDS_BYTES, "LDS map");

#define GAS __attribute__((address_space(1)))
#define LAS __attribute__((address_space(3)))
typedef GAS unsigned gu32;
#define RLX_AGENT __ATOMIC_RELAXED, __HIP_MEMORY_SCOPE_AGENT
#define LDS_WAIT() asm volatile("s_waitcnt lgkmcnt(0)" ::: "memory")
#define VM_WAIT() asm volatile("s_waitcnt vmcnt(0)" ::: "memory")
__device__ __forceinline__ unsigned f2bf(float f) { unsigned u = __builtin_bit_cast(unsigned, f); return (u + 0x7fffu + ((u >> 16) & 1u)) >> 16; }
__device__ __forceinline__ unsigned pk2(float lo, float hi) { return f2bf(lo) | (f2bf(hi) << 16); }
__device__ __forceinline__ float bf2f(unsigned short b) { return __builtin_bit_cast(float, (unsigned)b << 16); }

#define XB_TMO      128
#define XB_XCNT(j)  (256  + 64 * (j))
#define XB_XSUB(j)  (1280 + 64 * (j))
#define XB_XGEN(j)  (2304 + 64 * (j))
#define XB_TOP      3328
#define XB_TOPGEN   3392
#define XCD_BAR_WORDS 3456
#define XB_SPIN_CAP (1u << 22)
__device__ __forceinline__ unsigned xb_ld(unsigned* p)              { return __hip_atomic_load(p, __ATOMIC_RELAXED, __HIP_MEMORY_SCOPE_AGENT); }
__device__ __forceinline__ unsigned xb_add(unsigned* p, unsigned v) { return __hip_atomic_fetch_add(p, v, __ATOMIC_RELAXED, __HIP_MEMORY_SCOPE_AGENT); }
__device__ __forceinline__ unsigned xb_xcc_id() { return (unsigned)__builtin_amdgcn_s_getreg((3 << 11) | 20) & 0xFu; }
#define XB_SPIN(cond, bar) do { unsigned _sp = 0; while (cond) { __builtin_amdgcn_s_sleep(1); \
    if ((++_sp & 255u) == 0u) { if (xb_ld(&(bar)[XB_TMO])) break; if (_sp > XB_SPIN_CAP) { atomicAdd(&(bar)[XB_TMO], 1u); break; } } } } while (0)
struct XcdBarrier { unsigned* bar; unsigned x; volatile LAS unsigned* st; };
__device__ __forceinline__ XcdBarrier xcd_barrier_post(unsigned* bar, volatile LAS unsigned* st) {
    XcdBarrier b; b.bar = bar; b.x = xb_xcc_id(); b.st = st;
    if (threadIdx.x == 0) (void)xb_add(&bar[XB_XCNT(b.x)], 1u);
    return b;
}
__device__ __forceinline__ void xcd_barrier_complete(unsigned* bar, unsigned x, unsigned& nloc, unsigned& nx) {
    const unsigned G = gridDim.x * gridDim.y * gridDim.z;
    unsigned sum, cnt, mine, sp = 0u;
    for (;;) {
        sum = 0u; cnt = 0u; mine = 0u;
#pragma unroll
        for (unsigned j = 0; j < 16; ++j) { const unsigned c = xb_ld(&bar[XB_XCNT(j)]); sum += c; cnt += (c > 0u) ? 1u : 0u; mine = (j == x) ? c : mine; }
        if (sum == G) break;
        __builtin_amdgcn_s_sleep(1);
        if ((++sp & 255u) == 0u) { if (xb_ld(&bar[XB_TMO])) break; if (sp > XB_SPIN_CAP) { atomicAdd(&bar[XB_TMO], 1u); break; } }
    }
    nloc = mine > 0u ? mine : 1u; nx = cnt > 0u ? cnt : 1u;
}
__device__ __forceinline__ void xcd_barrier(const XcdBarrier& b) {
    asm volatile("s_waitcnt vmcnt(0)" ::: "memory");
    __syncthreads();
    if (threadIdx.x == 0) {
        unsigned* bar = b.bar;
        __builtin_amdgcn_s_waitcnt(0);
        unsigned nloc = b.st[0], nx = b.st[1];
        if (nloc == 0u) { xcd_barrier_complete(bar, b.x, nloc, nx); b.st[0] = nloc; b.st[1] = nx; }
        const unsigned old = xb_add(&bar[XB_XSUB(b.x)], 1u);
        const unsigned gen = old / nloc;
        if (old + 1u == (gen + 1u) * nloc) {
            __builtin_amdgcn_fence(__ATOMIC_RELEASE, "agent");
            asm volatile("s_waitcnt vmcnt(0)" ::: "memory");
            const unsigned og = xb_add(&bar[XB_TOP], 1u);
            const unsigned tg = og / nx;
            if (og + 1u == (tg + 1u) * nx) xb_add(&bar[XB_TOPGEN], 1u);
            else XB_SPIN(xb_ld(&bar[XB_TOPGEN]) == tg, bar);
            __builtin_amdgcn_fence(__ATOMIC_ACQUIRE, "agent");
            xb_add(&bar[XB_XGEN(b.x)], 1u);
            asm volatile("s_waitcnt vmcnt(0)" ::: "memory");
        } else {
            XB_SPIN(xb_ld(&bar[XB_XGEN(b.x)]) == gen, bar);
            __builtin_amdgcn_fence(__ATOMIC_ACQUIRE, "agent");
            asm volatile("s_waitcnt vmcnt(0)" ::: "memory");
        }
    }
    __syncthreads();
}

struct Args { const float* in[13]; float* out; unsigned char* ws; int ph_lo, ph_hi, p7_dummy, p0_mask, skip_epi, pad; };

__device__ __forceinline__ float wave_sum(float v) {
#pragma unroll
    for (int o = 1; o < 64; o <<= 1) v += __shfl_xor(v, o);
    return v;
}

constexpr int T_IN = (DM / 64) * (INW / 256), T_OUT = (DM / 64) * (DM / 256), T_G = (DM / 64) * (DFF / 256), T_D = (DFF / 64) * (DM / 256);
constexpr int T_EARLY = T_IN, T_ALL = T_IN + T_OUT + 2 * T_G + T_D;
struct TileDesc { const float* W; const float* g; bf16_t* WT; int K, N, k0, n0, kind; };
__device__ __forceinline__ TileDesc tile_desc(int t, const float* w_in, const float* w_out, const float* w_gate, const float* w_up, const float* w_down, const float* norm_mix, const float* norm_ffn,
                                              bf16_t* Win, bf16_t* Wout, bf16_t* Wgu, bf16_t* Wd) {
    TileDesc d;
    if (t < T_IN) { d.W = w_in; d.g = norm_mix; d.WT = Win; d.K = DM; d.N = INW; d.kind = 0; }
    else if ((t -= T_IN) < T_OUT) { d.W = w_out; d.g = nullptr; d.WT = Wout; d.K = DM; d.N = DM; d.kind = 0; }
    else if ((t -= T_OUT) < T_G) { d.W = w_gate; d.g = norm_ffn; d.WT = Wgu; d.K = DM; d.N = DFF; d.kind = 1; }
    else if ((t -= T_G) < T_G) { d.W = w_up; d.g = norm_ffn; d.WT = Wgu; d.K = DM; d.N = DFF; d.kind = 2; }
    else { t -= T_G; d.W = w_down; d.g = nullptr; d.WT = Wd; d.K = DFF; d.N = DM; d.kind = 0; }
    const int nb = d.N / 256; d.k0 = 64 * (t / nb); d.n0 = 256 * (t % nb);
    return d;
}
__device__ __forceinline__ void tile_load(const TileDesc& d, f32x4 (&r)[8], float& gq, int wave, int lane) {
#pragma unroll
    for (int i = 0; i < 8; ++i) r[i] = *(const GAS f32x4*)(d.W + (size_t)(d.k0 + wave * 8 + i) * d.N + d.n0 + lane * 4);
    const float* gp = d.g ? d.g : d.W; const int gi = d.g ? d.k0 + wave * 8 + (lane & 7) : 0;
    gq = *(const GAS float*)(gp + gi);
}
__device__ __forceinline__ void tile_store(const TileDesc& d, const f32x4 (&r)[8], const float gq, LAS float* T, int wave, int lane) {
#pragma unroll
    for (int i = 0; i < 8; ++i) { const float gk = d.g ? __shfl(gq, i) : 1.0f; *(LAS f32x4*)(T + (wave * 8 + i) * 256 + ((lane * 4) ^ (wave << 2))) = r[i] * gk; }
    LDS_WAIT(); __syncthreads();
    const int c = lane & 7;
#pragma unroll
    for (int jj = 0; jj < 4; ++jj) { const int nl = wave * 32 + jj * 8 + (lane >> 3); const LAS float* sp = T + (8 * c) * 256 + (nl ^ (c << 2));
        u32x4 o; o.x = pk2(sp[0 * 256], sp[1 * 256]); o.y = pk2(sp[2 * 256], sp[3 * 256]); o.z = pk2(sp[4 * 256], sp[5 * 256]); o.w = pk2(sp[6 * 256], sp[7 * 256]);
        const int n = d.n0 + nl; const int drow = d.kind == 0 ? n : ((n >> 7) * 256 + (d.kind == 2 ? 128 : 0) + (n & 127));
        *(GAS u32x4*)(d.WT + (size_t)drow * d.K + d.k0 + 8 * c) = o; }
    LDS_WAIT(); __syncthreads();
}
#define P0_TILES(t_lo, t_hi, idx, G_) do { \
    LAS float* T_ = (LAS float*)(lds + RING_OFF); f32x4 r0_[8], r1_[8]; float g0_ = 1.f, g1_ = 1.f; int t_ = (t_lo) + (idx); \
    if (t_ < (t_hi)) { TileDesc d0_ = tile_desc(t_, w_in, w_out, w_gate, w_up, w_down, norm_mix, norm_ffn, Win, Wout, Wgu, Wd); tile_load(d0_, r0_, g0_, wave, lane); \
        for (;;) { \
            const int t1_ = t_ + (G_); TileDesc d1_ = d0_; if (t1_ < (t_hi)) { d1_ = tile_desc(t1_, w_in, w_out, w_gate, w_up, w_down, norm_mix, norm_ffn, Win, Wout, Wgu, Wd); tile_load(d1_, r1_, g1_, wave, lane); } \
            tile_store(d0_, r0_, g0_, T_, wave, lane); if (t1_ >= (t_hi)) break; \
            const int t2_ = t1_ + (G_); if (t2_ < (t_hi)) { d0_ = tile_desc(t2_, w_in, w_out, w_gate, w_up, w_down, norm_mix, norm_ffn, Win, Wout, Wgu, Wd); tile_load(d0_, r0_, g0_, wave, lane); } \
            tile_store(d1_, r1_, g1_, T_, wave, lane); if (t2_ >= (t_hi)) break; t_ = t2_; } } } while (0)

typedef unsigned short us4 __attribute__((ext_vector_type(4)));
constexpr int P2_ROWB = 272;

__device__ __forceinline__ void p2_daxis_unit(LAS unsigned char* lds, const bf16_t* Abuf, const bf16_t* CWT, bf16_t* Pt, int bb, int h, int bgrp, int agrp, int tid) {
    const int wid = tid >> 6, lane = tid & 63, fr = lane & 15, fq = lane >> 4;
    const bf16_t* cw = CWT + (size_t)h * 256 * 128;
#pragma unroll
    for (int i = 0; i < 8; ++i) { const int piece = tid + i * NTHR, r = piece >> 4, c = piece & 15; const u32x4 v = *(const GAS u32x4*)(cw + r * 128 + c * 8); *(LAS u32x4*)(lds + r * P2_ROWB + c * 16) = v; }
    const int pb = 8 * bgrp + wid, a0 = 16 * agrp;
    bf16x8 af[4];
#pragma unroll
    for (int ks = 0; ks < 4; ++ks) af[ks] = *(const GAS bf16x8*)(Abuf + (size_t)(bb * SEQ + 64 * (a0 + fr) + pb) * FW + h * 128 + ks * 32 + fq * 8);
    LDS_WAIT(); __syncthreads();
#pragma unroll 4
    for (int nt = 0; nt < 16; ++nt) {
        f32x4 acc = {0.f, 0.f, 0.f, 0.f};
#pragma unroll
        for (int ks = 0; ks < 4; ++ks) { const bf16x8 bfr = *(const LAS bf16x8*)(lds + (16 * nt + fr) * P2_ROWB + ks * 64 + fq * 16); acc = __builtin_amdgcn_mfma_f32_16x16x32_bf16(af[ks], bfr, acc, 0, 0, 0); }
        const int ep = 16 * nt + fr; const int prow = bb * 1024 + h * 128 + (ep & 127); const int kk0 = (ep >> 7) * SEQ + pb * 64 + a0 + 4 * fq;
        u32x2 w; w.x = pg8::cvt_pk_bf16(acc[0], acc[1]); w.y = pg8::cvt_pk_bf16(acc[2], acc[3]);
        *(GAS u32x2*)(Pt + (size_t)prow * KDFT + kk0) = w;
    }
    __syncthreads();
}

constexpr int F_INP = 144, F_INB = 128 * F_INP, F_TP = 272;
__device__ __forceinline__ void p3_fft_phase(LAS unsigned char* lds, const bf16_t* Pt, const bf16_t* M1, const bf16_t* M3, bf16_t* Ycat, int vcu, int G, int tid) {
    const int wid = tid >> 6, lane = tid & 63, fr = lane & 15, fq = lane >> 4;
    bf16x8 m1f[4], m3f[4][4];
#pragma unroll
    for (int ks = 0; ks < 4; ++ks) m1f[ks] = *(const GAS bf16x8*)(M1 + (16 * wid + fr) * 128 + ks * 32 + fq * 8);
#pragma unroll
    for (int ct = 0; ct < 4; ++ct)
#pragma unroll
        for (int ks = 0; ks < 4; ++ks) m3f[ct][ks] = *(const GAS bf16x8*)(M3 + (16 * ct + fr) * 128 + ks * 32 + fq * 8);
    LAS unsigned char* tp = lds + 2 * F_INB;
    u32x4 st0, st1;
    const int p0i = tid, p1i = tid + NTHR;
    int j = vcu; if (j >= 512) return;
    { const bf16_t* src = Pt + (size_t)((j >> 5) * 128 + (j & 31) * 4) * KDFT; st0 = *(const GAS u32x4*)(src + p0i * 8); st1 = *(const GAS u32x4*)(src + p1i * 8); }
    for (; j < 512; j += G) {
        const int n0 = (j >> 5) * 128 + (j & 31) * 4;
#pragma unroll 1
        for (int col = 0; col < 4; ++col) {
            LAS unsigned char* inb = lds + (col & 1) * F_INB;
            *(LAS u32x4*)(inb + (p0i >> 3) * F_INP + (p0i & 7) * 16) = st0; *(LAS u32x4*)(inb + (p1i >> 3) * F_INP + (p1i & 7) * 16) = st1;
            { int nn = -1; if (col < 3) nn = n0 + col + 1; else if (j + G < 512) nn = ((j + G) >> 5) * 128 + ((j + G) & 31) * 4;
              if (nn >= 0) { const bf16_t* src = Pt + (size_t)nn * KDFT; st0 = *(const GAS u32x4*)(src + p0i * 8); st1 = *(const GAS u32x4*)(src + p1i * 8); } }
            LDS_WAIT(); __syncthreads();
            f32x4 acc[4];
#pragma unroll
            for (int nt = 0; nt < 4; ++nt) { acc[nt] = (f32x4){0.f, 0.f, 0.f, 0.f};
#pragma unroll
                for (int ks = 0; ks < 4; ++ks) { const bf16x8 bfr = *(const LAS bf16x8*)(inb + ((ks >> 1) * 64 + 16 * nt + fr) * F_INP + ((ks & 1) * 32 + fq * 8) * 2); acc[nt] = __builtin_amdgcn_mfma_f32_16x16x32_bf16(m1f[ks], bfr, acc[nt], 0, 0, 0); } }
#pragma unroll
            for (int nt = 0; nt < 4; ++nt) { const int b = 16 * nt + fr;
#pragma unroll
                for (int dd = 0; dd < 2; ++dd) { const int d = 8 * wid + 2 * fq + dd; const float Tr = acc[nt][2 * dd], Ti = acc[nt][2 * dd + 1];
                    const float rev = (float)(b * d) * (1.0f / 4096.0f); const float cs = __builtin_amdgcn_cosf(rev), sn = __builtin_amdgcn_sinf(rev);
                    *(LAS unsigned*)(tp + (d * 4 + col) * F_TP + 4 * b) = pg8::cvt_pk_bf16(Tr * cs + Ti * sn, Ti * cs - Tr * sn); } }
        }
        LDS_WAIT(); __syncthreads();
#pragma unroll
        for (int mi = 0; mi < 2; ++mi) { const int mt = 2 * wid + mi;
            bf16x8 af[4];
#pragma unroll
            for (int ks = 0; ks < 4; ++ks) af[ks] = *(const LAS bf16x8*)(tp + (16 * mt + fr) * F_TP + ks * 64 + fq * 16);
#pragma unroll
            for (int ct = 0; ct < 4; ++ct) { f32x4 y = {0.f, 0.f, 0.f, 0.f};
#pragma unroll
                for (int ks = 0; ks < 4; ++ks) y = __builtin_amdgcn_mfma_f32_16x16x32_bf16(af[ks], m3f[ct][ks], y, 0, 0, 0);
                const int d = 4 * mt + fq, c = 16 * ct + fr, k = 64 * c + d;
                u32x2 w; w.x = pg8::cvt_pk_bf16(y[0], y[1]); w.y = pg8::cvt_pk_bf16(y[2], y[3]);
                *(GAS u32x2*)(Ycat + (size_t)((n0 >> 10) * SEQ + k) * DM + (n0 & 1023)) = w; } }
    }
    __syncthreads();
}

__device__ __forceinline__ void p2_spatial_unit(LAS unsigned char* lds, const bf16_t* VT, const bf16_t* Ubuf, const float* wsp, const float* bsp, const float* gsgu, bf16_t* Ycat, int b, int n, int h, int tid) {
    const int wid = tid >> 6, lane = tid & 63, fr = lane & 15, fq = lane >> 4;
    LAS float* red = (LAS float*)(lds + 40960);
    LAS float* rstdv = (LAS float*)(lds + 40960 + 4096);
    const int tok0 = b * SEQ + n * 128;
    {
        float s0 = 0.f, s1 = 0.f;
        const bf16_t* p = VT + (size_t)(128 * wid) * MTOK + tok0 + 2 * lane;
#pragma unroll 8
        for (int f = 0; f < 128; ++f) { const unsigned w = *(const GAS unsigned*)(p + (size_t)f * MTOK); const float a = bf2f((unsigned short)(w & 0xffffu)), c = bf2f((unsigned short)(w >> 16)); s0 += a * a; s1 += c * c; }
        red[wid * 128 + 2 * lane] = s0; red[wid * 128 + 2 * lane + 1] = s1;
    }
    bf16x8 af[4];
#pragma unroll
    for (int ks = 0; ks < 4; ++ks) af[ks] = *(const GAS bf16x8*)(VT + (size_t)(h * 128 + 16 * wid + fr) * MTOK + tok0 + ks * 32 + fq * 8);
    LDS_WAIT(); __syncthreads();
    if (tid < 128) { float s = 0.f;
#pragma unroll
        for (int w = 0; w < 8; ++w) s += red[w * 128 + tid];
        rstdv[tid] = 1.0f / sqrtf(s * (1.0f / 1024.0f) + EPS); }
    LDS_WAIT(); __syncthreads();
    const float* wh = wsp + (size_t)h * 128 * 128;
#pragma unroll
    for (int i = 0; i < 8; ++i) { const int piece = tid + i * NTHR, r = piece >> 5, c4 = (piece & 31) * 4; const f32x4 v = *(const GAS f32x4*)(wh + r * 128 + c4); const f32x4 rs = *(const LAS f32x4*)(rstdv + c4);
        u32x2 w; w.x = pk2(v[0] * rs[0], v[1] * rs[1]); w.y = pk2(v[2] * rs[2], v[3] * rs[3]); *(LAS u32x2*)(lds + r * P2_ROWB + c4 * 2) = w; }
    LDS_WAIT(); __syncthreads();
    const int d0 = 16 * wid + 4 * fq;
    const f32x4 gv = *(const GAS f32x4*)(gsgu + h * 128 + d0);
#pragma unroll 4
    for (int nt = 0; nt < 8; ++nt) {
        f32x4 acc = {0.f, 0.f, 0.f, 0.f};
#pragma unroll
        for (int ks = 0; ks < 4; ++ks) { const bf16x8 bfr = *(const LAS bf16x8*)(lds + (16 * nt + fr) * P2_ROWB + ks * 64 + fq * 16); acc = __builtin_amdgcn_mfma_f32_16x16x32_bf16(af[ks], bfr, acc, 0, 0, 0); }
        const int p = 16 * nt + fr; const float bias = bsp[h * 128 + p];
        const u32x2 uw = *(const GAS u32x2*)(Ubuf + (size_t)(tok0 + p) * GW + h * 128 + d0);
        const float u0 = bf2f((unsigned short)(uw.x & 0xffffu)), u1 = bf2f((unsigned short)(uw.x >> 16)), u2 = bf2f((unsigned short)(uw.y & 0xffffu)), u3 = bf2f((unsigned short)(uw.y >> 16));
        u32x2 w; w.x = pg8::cvt_pk_bf16(u0 * (gv[0] * acc[0] + bias), u1 * (gv[1] * acc[1] + bias)); w.y = pg8::cvt_pk_bf16(u2 * (gv[2] * acc[2] + bias), u3 * (gv[3] * acc[3] + bias));
        *(GAS u32x2*)(Ycat + (size_t)(tok0 + p) * DM + FW + h * 128 + d0) = w;
    }
    __syncthreads();
}

__global__ void __launch_bounds__(NTHR, 2) mk_fwd(Args args) {
    extern __shared__ __attribute__((aligned(16))) unsigned char lds_raw[];
    LAS unsigned char* lds = (LAS unsigned char*)lds_raw;
    volatile LAS unsigned* MISC = (volatile LAS unsigned*)(lds + MISC_OFF);
    const int tid = threadIdx.x, lane = tid & 63, wave = __builtin_amdgcn_readfirstlane(tid >> 6);
    const int G = gridDim.x; const int bx = blockIdx.x; const int vcu = (G % 8 == 0) ? (bx % 8) * (G / 8) + bx / 8 : bx;
    unsigned char* ws = args.ws;
    gu32* ctl = (gu32*)(ws + WS_CTL);
    const float* x = args.in[0]; const float* norm_mix = args.in[1]; const float* w_in = args.in[2]; const float* w_fourier = args.in[3]; const float* sgu_norm = args.in[4];
    const float* w_spatial = args.in[5]; const float* b_spatial = args.in[6]; const float* w_out = args.in[7]; const float* norm_ffn = args.in[8];
    const float* w_gate = args.in[9]; const float* w_up = args.in[10]; const float* w_down = args.in[11]; const float* norm_final = args.in[12];
    float* out = args.out;
    bf16_t* Wgu = (bf16_t*)(ws + WS_WGU); bf16_t* Wd = (bf16_t*)(ws + WS_WD); bf16_t* Wout = (bf16_t*)(ws + WS_WOUT);
    bf16_t* Abuf = (bf16_t*)(ws + WS_A); bf16_t* Ubuf = (bf16_t*)(ws + WS_U); bf16_t* VT = (bf16_t*)(ws + WS_VT); bf16_t* XB = (bf16_t*)(ws + WS_XB); bf16_t* Pt = (bf16_t*)(ws + WS_PT);
    bf16_t* Win = (bf16_t*)(ws + WS_WIN); bf16_t* Ycat = (bf16_t*)(ws + WS_YCAT); bf16_t* X1B = (bf16_t*)(ws + WS_X1B); bf16_t* Hb = (bf16_t*)(ws + WS_H);
    float* rstd1 = (float*)(ws + WS_RSTD1); float* ss1 = (float*)(ws + WS_SS1); float* ss2 = (float*)(ws + WS_SS2); bf16_t* CWT = (bf16_t*)(ws + WS_CWT); bf16_t* M1 = (bf16_t*)(ws + WS_M1); bf16_t* M3 = (bf16_t*)(ws + WS_M3);

    for (int u = tid; u < (TAB_OFF - LDSCTL_OFF) / 4; u += NTHR) ((LAS unsigned*)(lds + LDSCTL_OFF))[u] = 0u;
    __syncthreads();
    XcdBarrier bar; bar.bar = (unsigned*)(ctl + CW_BAR); bar.x = 0; bar.st = nullptr;
    if (!MK_PER_PHASE) bar = xcd_barrier_post((unsigned*)(ctl + CW_BAR), MISC + 8);
    const int lo = args.ph_lo, hi = args.ph_hi;
#define IN(k) (lo <= (k) && (k) < hi)
#if defined(MK_PROBE) || defined(MK_PROBE_P7)
#define STAMP(k) do { if (tid == 0) MISC[16 + (k)] = (unsigned)__builtin_amdgcn_s_memrealtime(); } while (0)
#else
#define STAMP(k) do { } while (0)
#endif
#define SEAM(k) do { if (IN(k) && IN((k) + 1)) xcd_barrier(bar); STAMP((k) + 1); } while (0)

    STAMP(0);
    if (IN(0)) {
        LAS float* tab = (LAS float*)(lds + TAB_OFF);
        for (int i = tid; i < 4096; i += NTHR) tab[i] = cospif((float)i * (1.0f / 2048.0f));
        __syncthreads();
        const int gw = vcu * NWAVES + wave, NGW = G * NWAVES;
#define P0_XLOAD(v_, m_) do { const GAS f32x4* xr_ = (const GAS f32x4*)(x + (size_t)(m_) * DM) + lane; _Pragma("unroll") for (int j = 0; j < 8; ++j) v_[j] = xr_[64 * j]; } while (0)
#define P0_XDONE(v_, m_) do { float s_ = 0.f; _Pragma("unroll") for (int j = 0; j < 8; ++j) s_ += (v_[j].x * v_[j].x + v_[j].y * v_[j].y) + (v_[j].z * v_[j].z + v_[j].w * v_[j].w); \
            s_ = wave_sum(s_); if (lane == 0) rstd1[m_] = 1.0f / sqrtf(s_ * (1.0f / DM) + EPS); \
            GAS unsigned long long* o8_ = (GAS unsigned long long*)(XB + (size_t)(m_) * DM) + lane; \
            _Pragma("unroll") for (int j = 0; j < 8; ++j) o8_[64 * j] = (unsigned long long)pk2(v_[j].x, v_[j].y) | ((unsigned long long)pk2(v_[j].z, v_[j].w) << 32); } while (0)
        if (args.p0_mask & 1) { f32x4 va[8], vb[8]; int m = gw;
            if (m < MTOK) { P0_XLOAD(va, m);
                for (;;) { const int m1 = m + NGW; if (m1 < MTOK) P0_XLOAD(vb, m1); P0_XDONE(va, m); if (m1 >= MTOK) break;
                           const int m2 = m1 + NGW; if (m2 < MTOK) P0_XLOAD(va, m2); P0_XDONE(vb, m1); if (m2 >= MTOK) break; m = m2; } } }
        if (args.p0_mask & 2) P0_TILES(0, T_ALL, vcu, G);
        if (args.p0_mask & 4) for (int i = gw * 64 + lane; i < 128 * 128 + 64 * 128; i += NGW * 64) {
            if (i < 128 * 128) { const int dp = i >> 7, k = i & 127, d = dp >> 1, ri = dp & 1, part = k >> 6, a = k & 63; const float rev = (float)((a * d) & 63) * (1.0f / 64.0f);
                const float cs = __builtin_amdgcn_cosf(rev), sn = __builtin_amdgcn_sinf(rev); const float v = ri == 0 ? (part == 0 ? cs : -sn) : (part == 0 ? -sn : -cs);
                M1[i] = (bf16_t)f2bf(v * 0.125f); }
            else { const int q = i - 128 * 128, c = q >> 7, k = q & 127, b = k >> 1, ri = k & 1; const float rev = (float)((b * c) & 63) * (1.0f / 64.0f);
                M3[q] = (bf16_t)f2bf((ri == 0 ? __builtin_amdgcn_cosf(rev) : __builtin_amdgcn_sinf(rev)) * 0.125f); }
        }
        if (args.p0_mask & 8) for (int it = gw; it < 8 * 256; it += NGW) {
            const int h = it >> 8, ep = it & 255, e = ep & 127, ph = (ep >> 7) * 3072;
            const float* wf = w_fourier + (size_t)h * 16384 + e; float a0 = 0.f, a1 = 0.f;
            const float wlo = wf[lane * 128], whi = wf[(lane + 64) * 128];
#pragma unroll 8
            for (int j = 0; j < 64; ++j) { const float w0 = __shfl(wlo, j), w1 = __shfl(whi, j);
                a0 += tab[(((lane * j) & 127) * 32 + ph) & 4095] * w0 + tab[(((lane * (j + 64)) & 127) * 32 + ph) & 4095] * w1;
                a1 += tab[((((lane + 64) * j) & 127) * 32 + ph) & 4095] * w0 + tab[((((lane + 64) * (j + 64)) & 127) * 32 + ph) & 4095] * w1; }
            bf16_t* o = CWT + (size_t)it * 128; o[lane] = (bf16_t)f2bf(a0 * 0.08838834764831845f); o[lane + 64] = (bf16_t)f2bf(a1 * 0.08838834764831845f);
        }
    }
    SEAM(0);

    if (IN(1)) {
        pg8::Order S; S.init(MTOK, INW, DM, G, bx, XB, Win, 8);
        pg8::EpiIn E{Abuf, Ubuf, VT, rstd1};
        pg8::gemm_phase<pg8::EpiIn, pg8::Order, true, true>(lds + RING_OFF, DM, S, E);
    }
    SEAM(1);

    if (IN(2)) {
        for (int i = 0; i < 2; ++i) { const int j = vcu * 2 + i; if (j < 512) { const int h = j & 7, bn = j >> 3; p2_spatial_unit(lds, VT, Ubuf, w_spatial, b_spatial, sgu_norm, Ycat, bn >> 5, bn & 31, h, tid); } }
        for (int i = 0; i < 2; ++i) { const int j = vcu * 2 + i; if (j < 512) { const int h = j & 7, rest = j >> 3; p2_daxis_unit(lds, Abuf, CWT, Pt, rest >> 5, h, (rest >> 2) & 7, rest & 3, tid); } }
        if (G != 256) { for (int j = 2 * G + vcu; j < 512; j += G) { const int h = j & 7, bn = j >> 3; p2_spatial_unit(lds, VT, Ubuf, w_spatial, b_spatial, sgu_norm, Ycat, bn >> 5, bn & 31, h, tid); p2_daxis_unit(lds, Abuf, CWT, Pt, bn >> 5, h, (bn >> 2) & 7, bn & 3, tid); } }
    }
    SEAM(2);

    if (IN(3)) {
        p3_fft_phase(lds, Pt, M1, M3, Ycat, vcu, G, tid);
    }
    SEAM(3);

    if (IN(4)) {
        pg8::Order S; S.init(MTOK, DM, DM, G, bx, Ycat, Wout);
        pg8::EpiRes<true> E{x, out, X1B, ss1, args.skip_epi};
        pg8::gemm_phase<pg8::EpiRes<true>, pg8::Order, false, true>(lds + RING_OFF, DM, S, E);
    }
    SEAM(4);

    if (IN(5)) {
        pg8::Order S; S.init(MTOK, NGU, DM, G, bx, X1B, Wgu);
        pg8::EpiGU E{Hb, ss1};
        pg8::gemm_phase<pg8::EpiGU, pg8::Order, true, true>(lds + RING_OFF, DM, S, E);
    }
    SEAM(5);

    if (IN(6)) {
        pg8::Order S; S.init(MTOK, DM, DFF, G, bx, Hb, Wd);
        pg8::EpiRes<false> E{out, out, nullptr, ss2, args.skip_epi};
        pg8::gemm_phase<pg8::EpiRes<false>, pg8::Order, false, true>(lds + RING_OFF, DFF, S, E);
    }
    SEAM(6);

    if (IN(7)) {
        const int gw = vcu * NWAVES + wave, NGW = G * NWAVES;
#ifdef MK_PROBE
        __syncthreads();
        const float dA = (float)(MISC[16 + MK_PROBE_B + 1] - MISC[16 + MK_PROBE_A]) * 0.01f * MK_PROBE_SCALE, dB = (float)(MISC[16 + MK_PROBE_B + 1] - MISC[16 + MK_PROBE_B]) * 0.01f;
        (void)dB;
#endif
        f32x4 gf[8];
#pragma unroll
        for (int j = 0; j < 8; ++j) gf[j] = ((const GAS f32x4*)norm_final)[lane + 64 * j];
        for (int m = gw; m < MTOK; m += NGW) {
            const f32x4 p0 = *(const GAS f32x4*)(ss2 + (size_t)m * 8), p1 = *(const GAS f32x4*)(ss2 + (size_t)m * 8 + 4);
            const float ss = ((p0[0] + p0[1]) + (p0[2] + p0[3])) + ((p1[0] + p1[1]) + (p1[2] + p1[3]));
            const float r = 1.0f / sqrtf(ss * (1.0f / DM) + EPS);
            GAS f32x4* xr = (GAS f32x4*)(out + (size_t)m * DM) + lane; GAS f32x4* xw = args.p7_dummy ? (GAS f32x4*)((float*)(ws + WS_ADFT) + (size_t)m * DM) + lane : xr;
#pragma unroll
            for (int j = 0; j < 8; ++j) { f32x4 v = xr[64 * j]; v = v * r * gf[j];
#ifdef MK_PROBE
                if (m == 0 && lane == 0 && j == 0) v.x += dA * 0.001f;
#endif
                xw[64 * j] = v; }
        }
#ifdef MK_PROBE_P7
        asm volatile("s_waitcnt vmcnt(0)" ::: "memory");
        if (gw == 0 && lane == 0) out[1] += (float)((unsigned)__builtin_amdgcn_s_memrealtime() - MISC[16 + 7]) * 0.01f * 0.001f;
#endif
    }
#undef IN
#undef SEAM
}

static void launch(hipStream_t stream, void* const* d_in, void* d_out, void* d_ws) {
    static int grid = 0;
    if (grid == 0) {
        int dev = 0, cus = 0;
        if (hipGetDevice(&dev) != hipSuccess || hipDeviceGetAttribute(&cus, hipDeviceAttributeMultiprocessorCount, dev) != hipSuccess) { fprintf(stderr, "kernel_launch: device query failed\n"); grid = -1; return; }
        if (hipFuncSetAttribute((const void*)mk_fwd, hipFuncAttributeMaxDynamicSharedMemorySize, LDS_BYTES) != hipSuccess) { fprintf(stderr, "kernel_launch: hipFuncSetAttribute failed\n"); grid = -1; return; }
        int per_cu = 0;
        if (hipOccupancyMaxActiveBlocksPerMultiprocessor(&per_cu, (const void*)mk_fwd, NTHR, LDS_BYTES) != hipSuccess || per_cu < 1) fprintf(stderr, "kernel_launch: occupancy query reports %d workgroups per CU\n", per_cu);
        (void)hipGetLastError();
        grid = cus;
        if (grid != 256) fprintf(stderr, "kernel_launch: %d CUs; this kernel is laid out for 256 (the one-unit-per-workgroup phases need exactly 256 workgroups)\n", grid);
        grid = 256;
    }
    if (grid < 0) return;
    if (hipMemsetAsync((char*)d_ws + WS_CTL, 0, CTL_ZERO_BYTES, stream) != hipSuccess) { fprintf(stderr, "kernel_launch: memset failed\n"); return; }
#ifdef MK_EXTRA_MEMSET
    for (int q = 0; q < MK_EXTRA_MEMSET; ++q) (void)hipMemsetAsync((char*)d_ws + 254 * MiB + q * 65536, 0, CTL_ZERO_BYTES, stream);
#endif
    Args a{};
    for (int i = 0; i < 13; ++i) a.in[i] = (const float*)d_in[i];
    a.out = (float*)d_out; a.ws = (unsigned char*)d_ws; a.p7_dummy = 0; a.p0_mask = 15;
#if MK_PER_PHASE
    for (int p = 0; p < NPHASE; ++p) { a.ph_lo = p; a.ph_hi = p + 1; for (int r = 0; r < (p == MK_REPEAT ? 2 : 1); ++r) { a.p7_dummy = (p == 7 && MK_REPEAT == 7 && r == 0) ? 1 : 0; a.p0_mask = (p == 0 && r == 1) ? MK_P0MASK : 15; a.skip_epi = (r == 1 && (p == 4 || p == 6)) ? 1 : 0; hipLaunchKernelGGL(mk_fwd, dim3(grid), dim3(NTHR), LDS_BYTES, stream, a); } }
#else
    a.ph_lo = 0; a.ph_hi = NPHASE; hipLaunchKernelGGL(mk_fwd, dim3(grid), dim3(NTHR), LDS_BYTES, stream, a);
#endif
    const hipError_t le = hipPeekAtLastError();
    if (le != hipSuccess) fprintf(stderr, "kernel_launch: launch failed: %s\n", hipGetErrorName(le));
}
}
extern "C" void kernel_launch(void* const* d_in, const int* in_sizes, int n_in, void* d_out, int out_size, void* d_ws, size_t ws_size, hipStream_t stream) {
    (void)in_sizes; (void)n_in; (void)out_size; (void)ws_size;
    fp::launch(stream, d_in, d_out, d_ws);
}
```

```cpp
#include <hip/hip_runtime.h>
#include <cstdio>
#include <cstdint>
namespace pg8 {
#define PG8_LAS __attribute__((address_space(3)))
typedef unsigned short bf16_t;
typedef short bf16x8 __attribute__((ext_vector_type(8)));
typedef float f32x4 __attribute__((ext_vector_type(4)));
typedef float f32x2 __attribute__((ext_vector_type(2)));
typedef unsigned u32x4 __attribute__((ext_vector_type(4)));
typedef unsigned u32x2 __attribute__((ext_vector_type(2)));
constexpr int BM = 256, BK = 64, HALF = 128, HTB = HALF * BK * 2  , STAGE_BYTES = 8 * HTB, NXCD = 8, WGM = 8;

__host__ __device__ __forceinline__ int lds_byte(int r, int c) { const int st = (r >> 4) * 2 + (c >> 5), rr = r & 15, cc = c & 31, ob = rr * 64 + cc * 2; return st * 1024 + (ob ^ (((ob >> 9) & 1) << 5)); }
__host__ __device__ __forceinline__ void stage_rc(int b, int& R, int& C) { const int st = b / 1024, sb = b % 1024, swz = sb ^ (((sb >> 9) & 1) << 5); R = (st >> 1) * 16 + swz / 64; C = (st & 1) * 32 + (swz % 64) / 2; }
__host__ __device__ __forceinline__ int perm32(int rho) { const int n = rho >> 4, i = rho & 15; return 8 * (i >> 2) + 4 * n + (i & 3); }

struct Unit { int pm, pn; };

struct Order {
    int nM, nN, nwg, G, c; const char* A; const char* B; size_t tstep; int swap_from;
    __device__ void init(int M, int N, int K, int G_, int c_, const void* A_, const void* B_, int swap_from_ = 1 << 30) { nM = M / BM; nN = N / BM; nwg = nM * nN; G = G_; c = c_; A = (const char*)A_; B = (const char*)B_; tstep = (size_t)BM * K * 2; swap_from = swap_from_; }
    __device__ bool next(int i, Unit& u) const {
        const long L = (long)i * G + c; if (L >= nwg) return false;
        int wgid = (int)L; { const int q = nwg / NXCD, r = nwg % NXCD, xcd = wgid % NXCD, off = wgid / NXCD; wgid = (xcd < r ? xcd * (q + 1) : r * (q + 1) + (xcd - r) * q) + off; }
        const int nig = WGM * nN, gid = wgid / nig, fm = gid * WGM, gsz = (nM - fm) < WGM ? (nM - fm) : WGM;
        u.pm = fm + ((wgid % nig) % gsz); u.pn = (wgid % nig) / gsz; return true;
    }
    __device__ __forceinline__ const char* aptr(const Unit& u) const { return u.pn >= swap_from ? B + (size_t)u.pn * tstep : A + (size_t)u.pm * tstep; }
    __device__ __forceinline__ const char* bptr(const Unit& u) const { return u.pn >= swap_from ? A + (size_t)u.pm * tstep : B + (size_t)u.pn * tstep; }
    __device__ __forceinline__ void a_ready(const Unit&) const {}
    __device__ __forceinline__ void done(const Unit&) const {}
};

typedef __bf16 bf16x2_t __attribute__((ext_vector_type(2)));
__device__ __forceinline__ unsigned cvt_pk_bf16(float lo, float hi) { f32x2 v = {lo, hi}; bf16x2_t b = __builtin_convertvector(v, bf16x2_t); return __builtin_bit_cast(unsigned, b); }
__device__ __forceinline__ u32x4 pack8(const f32x4 v0, const f32x4 v1) { u32x4 w; w.x = cvt_pk_bf16(v0[0], v0[1]); w.y = cvt_pk_bf16(v0[2], v0[3]); w.z = cvt_pk_bf16(v1[0], v1[1]); w.w = cvt_pk_bf16(v1[2], v1[3]); return w; }
__device__ __forceinline__ float gelu_t(float x) { const float u = x * (0.7978845608f + 0.0356774081f * x * x); return x * __builtin_amdgcn_rcpf(1.0f + __builtin_amdgcn_exp2f(-2.8853900818f * u)); }
__device__ __forceinline__ f32x4 gelu4(f32x4 v) { return (f32x4){gelu_t(v[0]), gelu_t(v[1]), gelu_t(v[2]), gelu_t(v[3])}; }
__device__ __forceinline__ float silu_f(float x) { return x * __builtin_amdgcn_rcpf(1.0f + __builtin_amdgcn_exp2f(-1.4426950409f * x)); }


struct EpiIn {
    static constexpr bool PERM = true, AFTER_DRAIN = false;
    bf16_t* Abuf; bf16_t* Ubuf; bf16_t* VT; const float* rstd1;
    __device__ __forceinline__ void operator()(const f32x4 (&acc)[2][2][4][2], const Unit& u, int wr, int wc, int fr, int fq) const {
        const int kind = u.pn >> 2;
        if (kind < 2) {
            bf16_t* base = kind == 0 ? Abuf : Ubuf;
            const int row0 = u.pm * BM + wr * 64 + fr, col0 = (u.pn & 3) * BM + wc * 32 + 8 * fq;
#pragma unroll
            for (int ai = 0; ai < 2; ++ai)
#pragma unroll
                for (int m = 0; m < 4; ++m) { const int row = row0 + ai * HALF + m * 16; const float rs = rstd1[row]; bf16_t* rowp = base + (size_t)row * 1024 + col0;
#pragma unroll
                    for (int bj = 0; bj < 2; ++bj) { f32x4 v0 = acc[ai][bj][m][0] * rs, v1 = acc[ai][bj][m][1] * rs;
                        if (kind == 1) { v0 = gelu4(v0); v1 = gelu4(v1); }
                        *(u32x4*)(rowp + bj * HALF) = pack8(v0, v1); } }
        } else {
            const int f0 = (u.pn - 8) * BM + wr * 64 + fr, t0 = u.pm * BM + wc * 32 + 8 * fq;
            f32x4 rs[2][2];
#pragma unroll
            for (int bj = 0; bj < 2; ++bj) { rs[bj][0] = *(const f32x4*)(rstd1 + t0 + bj * HALF); rs[bj][1] = *(const f32x4*)(rstd1 + t0 + bj * HALF + 4); }
#pragma unroll
            for (int ai = 0; ai < 2; ++ai)
#pragma unroll
                for (int m = 0; m < 4; ++m) { bf16_t* rowp = VT + (size_t)(f0 + ai * HALF + m * 16) * 8192 + t0;
#pragma unroll
                    for (int bj = 0; bj < 2; ++bj) { const f32x4 v0 = gelu4(acc[ai][bj][m][0] * rs[bj][0]), v1 = gelu4(acc[ai][bj][m][1] * rs[bj][1]);
                        *(u32x4*)(rowp + bj * HALF) = pack8(v0, v1); } }
        }
    }
};
struct EpiDft {
    static constexpr bool PERM = true, AFTER_DRAIN = false;
    bf16_t* Ycat;
    __device__ __forceinline__ void operator()(const f32x4 (&acc)[2][2][4][2], const Unit& u, int wr, int wc, int fr, int fq) const {
        const int row0 = (u.pn >> 2) * 4096 + u.pm * BM + wr * 64 + fr, col0 = (u.pn & 3) * BM + wc * 32 + 8 * fq;
#pragma unroll
        for (int ai = 0; ai < 2; ++ai)
#pragma unroll
            for (int m = 0; m < 4; ++m) { bf16_t* rowp = Ycat + (size_t)(row0 + ai * HALF + m * 16) * 2048 + col0;
#pragma unroll
                for (int bj = 0; bj < 2; ++bj) *(u32x4*)(rowp + bj * HALF) = pack8(acc[ai][bj][m][0], acc[ai][bj][m][1]); }
    }
};
struct EpiGU {
    static constexpr bool PERM = true, AFTER_DRAIN = false;
    bf16_t* Hb; const float* ss1;
    __device__ __forceinline__ void operator()(const f32x4 (&acc)[2][2][4][2], const Unit& u, int wr, int wc, int fr, int fq) const {
        const int row0 = u.pm * BM + wr * 64 + fr, col0 = u.pn * HALF + wc * 32 + 8 * fq;
#pragma unroll
        for (int ai = 0; ai < 2; ++ai)
#pragma unroll
            for (int m = 0; m < 4; ++m) { const int row = row0 + ai * HALF + m * 16;
                const f32x4 p0 = *(const f32x4*)(ss1 + (size_t)row * 8), p1 = *(const f32x4*)(ss1 + (size_t)row * 8 + 4);
                const float ss = ((p0[0] + p0[1]) + (p0[2] + p0[3])) + ((p1[0] + p1[1]) + (p1[2] + p1[3]));
                const float r = 1.0f / sqrtf(ss * (1.0f / 2048.0f) + 1e-6f);
                f32x4 h0, h1;
#pragma unroll
                for (int j = 0; j < 4; ++j) { h0[j] = silu_f(acc[ai][0][m][0][j] * r) * (acc[ai][1][m][0][j] * r); h1[j] = silu_f(acc[ai][0][m][1][j] * r) * (acc[ai][1][m][1][j] * r); }
                *(u32x4*)(Hb + (size_t)row * 5632 + col0) = pack8(h0, h1); }
    }
};
template <bool WRITE_BF16> struct EpiRes {
    static constexpr bool PERM = true, AFTER_DRAIN = true;
    const float* base; float* out; bf16_t* outb; float* ssp; int skip; const float* gcol;
    __device__ __forceinline__ void fused(f32x4 (&acc)[2][2][4][2], const Unit& u, int wr, int wc, int fr, int fq, PG8_LAS unsigned char* lds, int wid, int lane) const {
        if (skip) { asm volatile("" :: "v"(acc[0][0][0][0]), "v"(acc[1][1][3][1])); return; }
        PG8_LAS float* P = (PG8_LAS float*)lds;
        const int col0 = u.pn * BM + wc * 32 + 8 * fq;
#pragma unroll
        for (int ai = 0; ai < 2; ++ai)
#pragma unroll
            for (int m = 0; m < 4; ++m) { const int rl = ai * HALF + wr * 64 + m * 16 + fr; const size_t off = (size_t)(u.pm * BM + rl) * 2048 + col0; float ss = 0.f;
#pragma unroll
                for (int bj = 0; bj < 2; ++bj) { const f32x4 b0 = *(const f32x4*)(base + off + bj * HALF), b1 = *(const f32x4*)(base + off + bj * HALF + 4);
                    const f32x4 v0 = b0 + acc[ai][bj][m][0], v1 = b1 + acc[ai][bj][m][1];
                    *(f32x4*)(out + off + bj * HALF) = v0; *(f32x4*)(out + off + bj * HALF + 4) = v1;
                    if (WRITE_BF16) { const f32x4 g0 = *(const f32x4*)(gcol + col0 + bj * HALF), g1 = *(const f32x4*)(gcol + col0 + bj * HALF + 4); *(u32x4*)(outb + off + bj * HALF) = pack8(v0 * g0, v1 * g1); }
                    ss += ((v0[0] * v0[0] + v0[1] * v0[1]) + (v0[2] * v0[2] + v0[3] * v0[3])) + ((v1[0] * v1[0] + v1[1] * v1[1]) + (v1[2] * v1[2] + v1[3] * v1[3])); }
                ss += __shfl_xor(ss, 16); ss += __shfl_xor(ss, 32);
                if (fq == 0) P[rl * 4 + wc] = ss;
                asm volatile("" ::: "memory"); }
        asm volatile("s_waitcnt lgkmcnt(0)" ::: "memory"); __builtin_amdgcn_s_barrier(); asm volatile("" ::: "memory");
        const int tid = wid * 64 + lane;
        if (tid < 256) { const f32x4 p = *(const PG8_LAS f32x4*)(P + tid * 4); ssp[(size_t)(u.pm * BM + tid) * 8 + u.pn] = (p[0] + p[1]) + (p[2] + p[3]); }
    }
};

template <class Epi, class Sched, bool ALIGN_EPI = false, bool SP2 = false>
__device__ __forceinline__ void gemm_phase(PG8_LAS unsigned char* lds, const int K, const Sched& S, const Epi& E) {
    const int tid = threadIdx.x, wid = __builtin_amdgcn_readfirstlane(tid >> 6), lane = tid & 63, wr = wid >> 2, wc = wid & 3, fr = lane & 15, fq = lane >> 4;
    const int nt = K / BK;
    unsigned voffA[2], voffB[2];
#pragma unroll
    for (int i = 0; i < 2; ++i) { int R, C; stage_rc(tid * 16 + i * 8192, R, C); const int Rb = Epi::PERM ? ((R & ~31) + perm32(R & 31)) : R;
        voffA[i] = (unsigned)(R * K + C) * 2u; voffB[i] = (unsigned)(Rb * K + C) * 2u; }
    const size_t kstep = (size_t)(BK * 2);
    const size_t hstep = (size_t)HALF * K * 2;
    const unsigned ldsw = (unsigned)wid * 1024u;
    const int aoff = lds_byte(wr * 64 + fr, fq * 8), boff = lds_byte(wc * 32 + fr, fq * 8);
#define PG8_SA(b, h) (((b) * 2 + (h)) * HTB)
#define PG8_SB(b, h) ((4 + (b) * 2 + (h)) * HTB)
#define PG8_STAGE(bufoff, gbase, voff) do { _Pragma("unroll") for (int _i = 0; _i < 2; ++_i) \
        __builtin_amdgcn_global_load_lds((const unsigned*)((const char*)(gbase) + (voff)[_i]), (PG8_LAS unsigned*)(lds + (bufoff) + ldsw + _i * 8192), 16, 0, 0); } while (0)
#define PG8_LDA(dst, b, h) do { _Pragma("unroll") for (int m = 0; m < 4; ++m) _Pragma("unroll") for (int k = 0; k < 2; ++k) dst[m][k] = *(const PG8_LAS bf16x8*)(lds + PG8_SA(b, h) + aoff + m * 2048 + k * 1024); } while (0)
#define PG8_LDB(dst, b, h) do { _Pragma("unroll") for (int n = 0; n < 2; ++n) _Pragma("unroll") for (int k = 0; k < 2; ++k) dst[n][k] = *(const PG8_LAS bf16x8*)(lds + PG8_SB(b, h) + boff + n * 2048 + k * 1024); } while (0)
#define PG8_MMA(ai, bj, At, Bt) do { __builtin_amdgcn_s_setprio(1); _Pragma("unroll") for (int m = 0; m < 4; ++m) _Pragma("unroll") for (int n = 0; n < 2; ++n) _Pragma("unroll") for (int k = 0; k < 2; ++k) \
        acc[ai][bj][m][n] = __builtin_amdgcn_mfma_f32_16x16x32_bf16(Bt[n][k], At[m][k], acc[ai][bj][m][n], 0, 0, 0); __builtin_amdgcn_s_setprio(0); } while (0)
#define PG8_WAIT_V(n) asm volatile("s_waitcnt vmcnt(" #n ")" ::: "memory")
#define PG8_WAIT_L(n) asm volatile("s_waitcnt lgkmcnt(" #n ")" ::: "memory")
#define PG8_BAR __builtin_amdgcn_s_barrier()
#define PG8_SCHED __builtin_amdgcn_sched_barrier(0)
    Unit cur, nxt; int ui = 0;
    if (!S.next(0, cur)) return;
    f32x4 acc[2][2][4][2];
#pragma unroll
    for (int a = 0; a < 2; ++a)
#pragma unroll
        for (int b = 0; b < 2; ++b)
#pragma unroll
            for (int m = 0; m < 4; ++m)
#pragma unroll
                for (int n = 0; n < 2; ++n) acc[a][b][m][n] = (f32x4){0.f, 0.f, 0.f, 0.f};
    bf16x8 At[4][2], B0[2][2], B1[2][2];
    const char* cA = S.aptr(cur); const char* cB = S.bptr(cur);
    S.a_ready(cur);
    if constexpr (SP2) {
        PG8_STAGE(PG8_SB(0, 0), cB, voffB); PG8_STAGE(PG8_SB(0, 1), cB + hstep, voffB); PG8_STAGE(PG8_SA(0, 0), cA, voffA); PG8_STAGE(PG8_SA(0, 1), cA + hstep, voffA);
        if (wr == 1) PG8_BAR;
        PG8_WAIT_V(2); PG8_BAR;
        PG8_STAGE(PG8_SB(1, 0), cB + kstep, voffB); PG8_STAGE(PG8_SA(1, 0), cA + kstep, voffA); PG8_STAGE(PG8_SB(1, 1), cB + hstep + kstep, voffB);
        PG8_WAIT_V(6); PG8_BAR;
    } else {
        PG8_STAGE(PG8_SB(0, 0), cB, voffB); PG8_STAGE(PG8_SA(0, 0), cA, voffA); PG8_STAGE(PG8_SB(0, 1), cB + hstep, voffB); PG8_STAGE(PG8_SA(0, 1), cA + hstep, voffA);
        if (wr == 1) PG8_BAR;
        PG8_WAIT_V(4); PG8_BAR;
        PG8_STAGE(PG8_SB(1, 0), cB + kstep, voffB); PG8_STAGE(PG8_SA(1, 0), cA + kstep, voffA); PG8_STAGE(PG8_SB(1, 1), cB + hstep + kstep, voffB);
        PG8_WAIT_V(6); PG8_BAR;
    }
    for (;;) {
        const bool has_next = Epi::AFTER_DRAIN ? false : S.next(ui + 1, nxt);
        const char* nA = has_next ? S.aptr(nxt) : cA; const char* nB = has_next ? S.bptr(nxt) : cB;
        for (int t = 0; t < nt; t += 2) {
            const bool last = (t == nt - 2);
            const char* a1 = cA + (size_t)(t + 1) * kstep;
            const char* a2 = last ? nA : cA + (size_t)(t + 2) * kstep; const char* b2 = last ? nB : cB + (size_t)(t + 2) * kstep;
            const char* a3 = a2 + kstep; const char* b3 = b2 + kstep;
            if (last && has_next) S.a_ready(nxt);
            if constexpr (SP2) {
            PG8_LDB(B0, 0, 0); PG8_LDB(B1, 0, 1); PG8_SCHED; PG8_LDA(At, 0, 0); PG8_STAGE(PG8_SA(1, 1), a1 + hstep, voffA);
            PG8_WAIT_V(8); PG8_WAIT_L(0); PG8_BAR; PG8_MMA(0, 0, At, B0); PG8_MMA(0, 1, At, B1); PG8_BAR; PG8_SCHED;
            PG8_LDA(At, 0, 1); PG8_STAGE(PG8_SB(0, 0), b2, voffB); PG8_STAGE(PG8_SB(0, 1), b2 + hstep, voffB); PG8_STAGE(PG8_SA(0, 0), a2, voffA);
            PG8_WAIT_V(8); PG8_WAIT_L(0); PG8_BAR; PG8_MMA(1, 0, At, B0); PG8_MMA(1, 1, At, B1); PG8_BAR; PG8_SCHED;
            PG8_LDB(B0, 1, 0); PG8_LDB(B1, 1, 1); PG8_SCHED; PG8_LDA(At, 1, 0); PG8_STAGE(PG8_SA(0, 1), a2 + hstep, voffA);
            PG8_WAIT_V(8); PG8_WAIT_L(0); PG8_BAR; PG8_MMA(0, 0, At, B0); PG8_MMA(0, 1, At, B1); PG8_BAR; PG8_SCHED;
            PG8_LDA(At, 1, 1); PG8_STAGE(PG8_SB(1, 0), b3, voffB); PG8_STAGE(PG8_SB(1, 1), b3 + hstep, voffB); PG8_STAGE(PG8_SA(1, 0), a3, voffA);
            PG8_WAIT_V(8); PG8_WAIT_L(0); PG8_BAR; PG8_MMA(1, 0, At, B0); PG8_MMA(1, 1, At, B1); PG8_BAR; PG8_SCHED;
            } else {
            PG8_LDB(B0, 0, 0); PG8_SCHED; PG8_LDA(At, 0, 0); PG8_STAGE(PG8_SA(1, 1), a1 + hstep, voffA);
            PG8_WAIT_L(8); PG8_BAR; PG8_WAIT_L(0); PG8_MMA(0, 0, At, B0); PG8_BAR; PG8_SCHED;
            PG8_LDB(B1, 0, 1); PG8_STAGE(PG8_SB(0, 0), b2, voffB);
            PG8_BAR; PG8_WAIT_L(0); PG8_MMA(0, 1, At, B1); PG8_BAR;
            PG8_LDA(At, 0, 1); PG8_STAGE(PG8_SA(0, 0), a2, voffA);
            PG8_BAR; PG8_WAIT_L(0); PG8_MMA(1, 0, At, B0); PG8_BAR; PG8_SCHED;
            PG8_STAGE(PG8_SB(0, 1), b2 + hstep, voffB);
            PG8_WAIT_V(6); PG8_BAR; PG8_MMA(1, 1, At, B1); PG8_BAR;
            PG8_LDB(B0, 1, 0); PG8_SCHED; PG8_LDA(At, 1, 0); PG8_STAGE(PG8_SA(0, 1), a2 + hstep, voffA);
            PG8_WAIT_L(8); PG8_BAR; PG8_WAIT_L(0); PG8_MMA(0, 0, At, B0); PG8_BAR; PG8_SCHED;
            PG8_LDB(B1, 1, 1); PG8_STAGE(PG8_SB(1, 0), b3, voffB);
            PG8_BAR; PG8_WAIT_L(0); PG8_MMA(0, 1, At, B1); PG8_BAR;
            PG8_LDA(At, 1, 1); PG8_STAGE(PG8_SA(1, 0), a3, voffA);
            PG8_BAR; PG8_WAIT_L(0); PG8_MMA(1, 0, At, B0); PG8_BAR; PG8_SCHED;
            PG8_STAGE(PG8_SB(1, 1), b3 + hstep, voffB);
            PG8_WAIT_V(6); PG8_BAR; PG8_MMA(1, 1, At, B1); PG8_BAR;
            }
        }
        if constexpr (ALIGN_EPI) { if (wr == 0) PG8_BAR; }
        if constexpr (!Epi::AFTER_DRAIN) { E(acc, cur, wr, wc, fr, fq); S.done(cur); }
        if (!has_next) break;
#pragma unroll
        for (int a = 0; a < 2; ++a)
#pragma unroll
            for (int b = 0; b < 2; ++b)
#pragma unroll
                for (int m = 0; m < 4; ++m)
#pragma unroll
                    for (int n = 0; n < 2; ++n) acc[a][b][m][n] = (f32x4){0.f, 0.f, 0.f, 0.f};
        cur = nxt; cA = nA; cB = nB; ++ui;
        if constexpr (ALIGN_EPI) { if (wr == 1) PG8_BAR; }
    }
    PG8_WAIT_V(0);
    if constexpr (!ALIGN_EPI) { if (wr == 0) PG8_BAR; }
    PG8_BAR;
    if constexpr (Epi::AFTER_DRAIN) { E.fused(acc, cur, wr, wc, fr, fq, lds, wid, lane); S.done(cur); }
#undef PG8_SA
#undef PG8_SB
#undef PG8_STAGE
#undef PG8_LDA
#undef PG8_LDB
#undef PG8_MMA
#undef PG8_WAIT_V
#undef PG8_WAIT_L
#undef PG8_BAR
#undef PG8_SCHED
}
}

namespace fp {
using pg8::bf16_t; using pg8::bf16x8; using pg8::f32x4; using pg8::u32x4; using pg8::u32x2;
constexpr int NWAVES = 8, NTHR = 512;
constexpr int SEQ = 4096, DM = 2048, MTOK = 8192, INW = 3072, FW = 1024, GW = 1024, DFF = 5632, NGU = 11264, KDFT = 8192;
constexpr float EPS = 1e-6f;
constexpr int NPHASE = 8;
#ifndef MK_P0MASK
#define MK_P0MASK 15
#endif
#ifndef MK_PROBE_SCALE
#define MK_PROBE_SCALE 1.0f
#endif
#ifndef MK_REPEAT
#define MK_REPEAT -1
#endif
#ifndef MK_PER_PHASE
#define MK_PER_PHASE 0
#endif

constexpr size_t MiB = 1u << 20;
constexpr size_t WS_CTL = 0, CTL_ZERO_BYTES = 64 * 1024;
constexpr size_t WS_WGU = 1 * MiB;
constexpr size_t WS_WD = 45 * MiB;
constexpr size_t WS_WOUT = 67 * MiB;
constexpr size_t WS_ADFT = 75 * MiB;
constexpr size_t WS_A = 139 * MiB;
constexpr size_t WS_U = 155 * MiB;
constexpr size_t WS_VT = 171 * MiB;
constexpr size_t WS_XB = 187 * MiB;
constexpr size_t WS_PT = 187 * MiB;
constexpr size_t WS_WIN = 219 * MiB;
constexpr size_t WS_YCAT = 219 * MiB;
constexpr size_t WS_SMALL = 251 * MiB;
constexpr size_t WS_RSTD1 = WS_SMALL;
constexpr size_t WS_SS1 = WS_SMALL + 64 * 1024;
constexpr size_t WS_SS2 = WS_SS1 + 256 * 1024;
constexpr size_t WS_CWT = WS_SMALL + 1 * MiB;
constexpr size_t WS_M1 = WS_CWT + 512 * 1024;
constexpr size_t WS_M3 = WS_M1 + 32 * 1024;
constexpr size_t WS_X1B = 187 * MiB;
constexpr size_t WS_H = 75 * MiB;
constexpr size_t WS_END = 256 * MiB;
static_assert(WS_WGU + (size_t)NGU * DM * 2 <= WS_WD && WS_WD + (size_t)DM * DFF * 2 <= WS_WOUT && WS_WOUT + (size_t)DM * DM * 2 <= WS_ADFT && WS_ADFT + (size_t)SEQ * KDFT * 2 <= WS_A, "ws map 1");
static_assert(WS_VT + (size_t)GW * MTOK * 2 <= WS_XB && WS_XB + (size_t)MTOK * DM * 2 <= WS_WIN && WS_YCAT + (size_t)MTOK * DM * 2 <= WS_SMALL && WS_M3 + 64 * 128 * 2 <= 253 * MiB, "ws map 2");
static_assert(WS_H + (size_t)MTOK * DFF * 2 <= WS_VT, "ws map 3");
constexpr int CW_BAR = 4096;

constexpr int RING_OFF = 0, RING_BYTES = 131072;
constexpr int LDSCTL_OFF = RING_BYTES, MISC_OFF = LDSCTL_OFF + 320;
constexpr int TAB_OFF = 135168;
constexpr int LDS_BYTES = 155648;
static_assert(TAB_OFF >= MISC_OFF + 128 && TAB_OFF + 16384 <= LDS_BYTES, "LDS map");

#define GAS __attribute__((address_space(1)))
#define LAS __attribute__((address_space(3)))
typedef GAS unsigned gu32;
#define RLX_AGENT __ATOMIC_RELAXED, __HIP_MEMORY_SCOPE_AGENT
#define LDS_WAIT() asm volatile("s_waitcnt lgkmcnt(0)" ::: "memory")
#define VM_WAIT() asm volatile("s_waitcnt vmcnt(0)" ::: "memory")
__device__ __forceinline__ unsigned f2bf(float f) { unsigned u = __builtin_bit_cast(unsigned, f); return (u + 0x7fffu + ((u >> 16) & 1u)) >> 16; }
__device__ __forceinline__ unsigned pk2(float lo, float hi) { return f2bf(lo) | (f2bf(hi) << 16); }
__device__ __forceinline__ float bf2f(unsigned short b) { return __builtin_bit_cast(float, (unsigned)b << 16); }

#define XB_TMO      128
#define XB_XCNT(j)  (256  + 64 * (j))
#define XB_XSUB(j)  (1280 + 64 * (j))
#define XB_XGEN(j)  (2304 + 64 * (j))
#define XB_TOP      3328
#define XB_TOPGEN   3392
#define XCD_BAR_WORDS 3456
#define XB_SPIN_CAP (1u << 22)
__device__ __forceinline__ unsigned xb_ld(unsigned* p)              { return __hip_atomic_load(p, __ATOMIC_RELAXED, __HIP_MEMORY_SCOPE_AGENT); }
__device__ __forceinline__ unsigned xb_add(unsigned* p, unsigned v) { return __hip_atomic_fetch_add(p, v, __ATOMIC_RELAXED, __HIP_MEMORY_SCOPE_AGENT); }
__device__ __forceinline__ unsigned xb_xcc_id() { return (unsigned)__builtin_amdgcn_s_getreg((3 << 11) | 20) & 0xFu; }
#define XB_SPIN(cond, bar) do { unsigned _sp = 0; while (cond) { __builtin_amdgcn_s_sleep(1); \
    if ((++_sp & 255u) == 0u) { if (xb_ld(&(bar)[XB_TMO])) break; if (_sp > XB_SPIN_CAP) { atomicAdd(&(bar)[XB_TMO], 1u); break; } } } } while (0)
struct XcdBarrier { unsigned* bar; unsigned x; volatile LAS unsigned* st; };
__device__ __forceinline__ XcdBarrier xcd_barrier_post(unsigned* bar, volatile LAS unsigned* st) {
    XcdBarrier b; b.bar = bar; b.x = xb_xcc_id(); b.st = st;
    if (threadIdx.x == 0) (void)xb_add(&bar[XB_XCNT(b.x)], 1u);
    return b;
}
__device__ __forceinline__ void xcd_barrier_complete(unsigned* bar, unsigned x, unsigned& nloc, unsigned& nx) {
    const unsigned G = gridDim.x * gridDim.y * gridDim.z;
    unsigned sum, cnt, mine, sp = 0u;
    for (;;) {
        sum = 0u; cnt = 0u; mine = 0u;
#pragma unroll
        for (unsigned j = 0; j < 16; ++j) { const unsigned c = xb_ld(&bar[XB_XCNT(j)]); sum += c; cnt += (c > 0u) ? 1u : 0u; mine = (j == x) ? c : mine; }
        if (sum == G) break;
        __builtin_amdgcn_s_sleep(1);
        if ((++sp & 255u) == 0u) { if (xb_ld(&bar[XB_TMO])) break; if (sp > XB_SPIN_CAP) { atomicAdd(&bar[XB_TMO], 1u); break; } }
    }
    nloc = mine > 0u ? mine : 1u; nx = cnt > 0u ? cnt : 1u;
}
__device__ __forceinline__ void xcd_barrier(const XcdBarrier& b) {
    asm volatile("s_waitcnt vmcnt(0)" ::: "memory");
    __syncthreads();
    if (threadIdx.x == 0) {
        unsigned* bar = b.bar;
        __builtin_amdgcn_s_waitcnt(0);
        unsigned nloc = b.st[0], nx = b.st[1];
        if (nloc == 0u) { xcd_barrier_complete(bar, b.x, nloc, nx); b.st[0] = nloc; b.st[1] = nx; }
        const unsigned old = xb_add(&bar[XB_XSUB(b.x)], 1u);
        const unsigned gen = old / nloc;
        if (old + 1u == (gen + 1u) * nloc) {
            __builtin_amdgcn_fence(__ATOMIC_RELEASE, "agent");
            asm volatile("s_waitcnt vmcnt(0)" ::: "memory");
            const unsigned og = xb_add(&bar[XB_TOP], 1u);
            const unsigned tg = og / nx;
            if (og + 1u == (tg + 1u) * nx) xb_add(&bar[XB_TOPGEN], 1u);
            else XB_SPIN(xb_ld(&bar[XB_TOPGEN]) == tg, bar);
            __builtin_amdgcn_fence(__ATOMIC_ACQUIRE, "agent");
            xb_add(&bar[XB_XGEN(b.x)], 1u);
            asm volatile("s_waitcnt vmcnt(0)" ::: "memory");
        } else {
            XB_SPIN(xb_ld(&bar[XB_XGEN(b.x)]) == gen, bar);
            __builtin_amdgcn_fence(__ATOMIC_ACQUIRE, "agent");
            asm volatile("s_waitcnt vmcnt(0)" ::: "memory");
        }
    }
    __syncthreads();
}

struct Args { const float* in[13]; float* out; unsigned char* ws; int ph_lo, ph_hi, p7_dummy, p0_mask, skip_epi, pad; };

__device__ __forceinline__ float wave_sum(float v) {
#pragma unroll
    for (int o = 1; o < 64; o <<= 1) v += __shfl_xor(v, o);
    return v;
}

constexpr int T_IN = (DM / 64) * (INW / 256), T_OUT = (DM / 64) * (DM / 256), T_G = (DM / 64) * (DFF / 256), T_D = (DFF / 64) * (DM / 256);
constexpr int T_EARLY = T_IN, T_ALL = T_IN + T_OUT + 2 * T_G + T_D;
struct TileDesc { const float* W; bf16_t* WT; int K, N, k0, n0, kind; };
__device__ __forceinline__ TileDesc tile_desc(int t, const float* w_in, const float* w_out, const float* w_gate, const float* w_up, const float* w_down, bf16_t* Win, bf16_t* Wout, bf16_t* Wgu, bf16_t* Wd) {
    TileDesc d;
    if (t < T_IN) { d.W = w_in; d.WT = Win; d.K = DM; d.N = INW; d.kind = 0; }
    else if ((t -= T_IN) < T_OUT) { d.W = w_out; d.WT = Wout; d.K = DM; d.N = DM; d.kind = 0; }
    else if ((t -= T_OUT) < T_G) { d.W = w_gate; d.WT = Wgu; d.K = DM; d.N = DFF; d.kind = 1; }
    else if ((t -= T_G) < T_G) { d.W = w_up; d.WT = Wgu; d.K = DM; d.N = DFF; d.kind = 2; }
    else { t -= T_G; d.W = w_down; d.WT = Wd; d.K = DFF; d.N = DM; d.kind = 0; }
    const int nb = d.N / 256; d.k0 = 64 * (t / nb); d.n0 = 256 * (t % nb);
    return d;
}
__device__ __forceinline__ void tile_dma(const TileDesc& d, LAS unsigned char* buf, int wave, int lane) {
    const char* src = (const char*)(d.W + (size_t)(d.k0 + wave * 8) * d.N + d.n0) + ((lane ^ wave) << 4);
#pragma unroll
    for (int i = 0; i < 8; ++i) __builtin_amdgcn_global_load_lds((const unsigned*)(src + (size_t)i * d.N * 4), (LAS unsigned*)(buf + (wave * 8 + i) * 1024), 16, 0, 0);
}
__device__ __forceinline__ void tile_out(const TileDesc& d, const LAS unsigned char* buf, int wave, int lane) {
    const LAS float* T = (const LAS float*)buf; const int c = lane & 7;
#pragma unroll
    for (int jj = 0; jj < 4; ++jj) { const int nl = wave * 32 + jj * 8 + (lane >> 3); const LAS float* sp = T + (8 * c) * 256 + (nl ^ (c << 2));
        u32x4 o; o.x = pg8::cvt_pk_bf16(sp[0 * 256], sp[1 * 256]); o.y = pg8::cvt_pk_bf16(sp[2 * 256], sp[3 * 256]); o.z = pg8::cvt_pk_bf16(sp[4 * 256], sp[5 * 256]); o.w = pg8::cvt_pk_bf16(sp[6 * 256], sp[7 * 256]);
        const int n = d.n0 + nl; const int drow = d.kind == 0 ? n : ((n >> 7) * 256 + (d.kind == 2 ? 128 : 0) + (n & 127));
        *(GAS u32x4*)(d.WT + (size_t)drow * d.K + d.k0 + 8 * c) = o; }
}
#define P0_TILES(t_lo, t_hi, idx, G_) do { int t_ = (t_lo) + (idx); \
    if (t_ < (t_hi)) { TileDesc d0_ = tile_desc(t_, w_in, w_out, w_gate, w_up, w_down, Win, Wout, Wgu, Wd), d1_ = d0_; int b_ = 0; \
        asm volatile("s_waitcnt vmcnt(0) lgkmcnt(0)" ::: "memory"); __builtin_amdgcn_s_barrier(); asm volatile("" ::: "memory"); \
        tile_dma(d0_, lds + RING_OFF, wave, lane); \
        for (;;) { const int t1_ = t_ + (G_); const bool nx_ = t1_ < (t_hi); \
            if (nx_) { d1_ = tile_desc(t1_, w_in, w_out, w_gate, w_up, w_down, Win, Wout, Wgu, Wd); tile_dma(d1_, lds + RING_OFF + (b_ ^ 1) * 65536, wave, lane); asm volatile("s_waitcnt vmcnt(8)" ::: "memory"); } \
            else asm volatile("s_waitcnt vmcnt(0)" ::: "memory"); \
            __builtin_amdgcn_s_barrier(); asm volatile("" ::: "memory"); \
            tile_out(d0_, lds + RING_OFF + b_ * 65536, wave, lane); \
            asm volatile("s_waitcnt lgkmcnt(0)" ::: "memory"); __builtin_amdgcn_s_barrier(); asm volatile("" ::: "memory"); \
            if (!nx_) break; d0_ = d1_; t_ = t1_; b_ ^= 1; } } } while (0)

typedef unsigned short us4 __attribute__((ext_vector_type(4)));
constexpr int P2_ROWB = 272;

__device__ __forceinline__ void p2_daxis_unit(LAS unsigned char* lds, const bf16_t* Abuf, const bf16_t* CWT, bf16_t* Pt, int bb, int h, int bgrp, int agrp, int tid) {
    const int wid = tid >> 6, lane = tid & 63, fr = lane & 15, fq = lane >> 4;
    const bf16_t* cw = CWT + (size_t)h * 256 * 128;
#pragma unroll
    for (int i = 0; i < 8; ++i) { const int piece = tid + i * NTHR, r = piece >> 4, c = piece & 15; const u32x4 v = *(const GAS u32x4*)(cw + r * 128 + c * 8); *(LAS u32x4*)(lds + r * P2_ROWB + c * 16) = v; }
    const int pb = 8 * bgrp + wid, a0 = 16 * agrp;
    bf16x8 af[4];
#pragma unroll
    for (int ks = 0; ks < 4; ++ks) af[ks] = *(const GAS bf16x8*)(Abuf + (size_t)(bb * SEQ + 64 * (a0 + fr) + pb) * FW + h * 128 + ks * 32 + fq * 8);
    LDS_WAIT(); __syncthreads();
#pragma unroll 4
    for (int nt = 0; nt < 16; ++nt) {
        f32x4 acc = {0.f, 0.f, 0.f, 0.f};
#pragma unroll
        for (int ks = 0; ks < 4; ++ks) { const bf16x8 bfr = *(const LAS bf16x8*)(lds + (16 * nt + fr) * P2_ROWB + ks * 64 + fq * 16); acc = __builtin_amdgcn_mfma_f32_16x16x32_bf16(af[ks], bfr, acc, 0, 0, 0); }
        const int ep = 16 * nt + fr; const int prow = bb * 1024 + h * 128 + (ep & 127); const int kk0 = (ep >> 7) * SEQ + pb * 64 + a0 + 4 * fq;
        u32x2 w; w.x = pg8::cvt_pk_bf16(acc[0], acc[1]); w.y = pg8::cvt_pk_bf16(acc[2], acc[3]);
        *(GAS u32x2*)(Pt + (size_t)prow * KDFT + kk0) = w;
    }
    __syncthreads();
}

constexpr int F_INP = 144, F_INB = 128 * F_INP, F_TP = 272;
__device__ __forceinline__ void p3_fft_phase(LAS unsigned char* lds, const bf16_t* Pt, const bf16_t* M1, const bf16_t* M3, bf16_t* Ycat, int vcu, int G, int tid) {
    const int wid = tid >> 6, lane = tid & 63, fr = lane & 15, fq = lane >> 4;
    bf16x8 m1f[4], m3f[4][4];
#pragma unroll
    for (int ks = 0; ks < 4; ++ks) m1f[ks] = *(const GAS bf16x8*)(M1 + (16 * wid + fr) * 128 + ks * 32 + fq * 8);
#pragma unroll
    for (int ct = 0; ct < 4; ++ct)
#pragma unroll
        for (int ks = 0; ks < 4; ++ks) m3f[ct][ks] = *(const GAS bf16x8*)(M3 + (16 * ct + fr) * 128 + ks * 32 + fq * 8);
    LAS unsigned char* tp = lds + 2 * F_INB;
    u32x4 st0, st1;
    const int p0i = tid, p1i = tid + NTHR;
    int j = vcu; if (j >= 512) return;
    { const bf16_t* src = Pt + (size_t)((j >> 5) * 128 + (j & 31) * 4) * KDFT; st0 = *(const GAS u32x4*)(src + p0i * 8); st1 = *(const GAS u32x4*)(src + p1i * 8); }
    for (; j < 512; j += G) {
        const int n0 = (j >> 5) * 128 + (j & 31) * 4;
#pragma unroll 1
        for (int col = 0; col < 4; ++col) {
            LAS unsigned char* inb = lds + (col & 1) * F_INB;
            *(LAS u32x4*)(inb + (p0i >> 3) * F_INP + (p0i & 7) * 16) = st0; *(LAS u32x4*)(inb + (p1i >> 3) * F_INP + (p1i & 7) * 16) = st1;
            { int nn = -1; if (col < 3) nn = n0 + col + 1; else if (j + G < 512) nn = ((j + G) >> 5) * 128 + ((j + G) & 31) * 4;
              if (nn >= 0) { const bf16_t* src = Pt + (size_t)nn * KDFT; st0 = *(const GAS u32x4*)(src + p0i * 8); st1 = *(const GAS u32x4*)(src + p1i * 8); } }
            LDS_WAIT(); __syncthreads();
            f32x4 acc[4];
#pragma unroll
            for (int nt = 0; nt < 4; ++nt) { acc[nt] = (f32x4){0.f, 0.f, 0.f, 0.f};
#pragma unroll
                for (int ks = 0; ks < 4; ++ks) { const bf16x8 bfr = *(const LAS bf16x8*)(inb + ((ks >> 1) * 64 + 16 * nt + fr) * F_INP + ((ks & 1) * 32 + fq * 8) * 2); acc[nt] = __builtin_amdgcn_mfma_f32_16x16x32_bf16(m1f[ks], bfr, acc[nt], 0, 0, 0); } }
#pragma unroll
            for (int nt = 0; nt < 4; ++nt) { const int b = 16 * nt + fr;
#pragma unroll
                for (int dd = 0; dd < 2; ++dd) { const int d = 8 * wid + 2 * fq + dd; const float Tr = acc[nt][2 * dd], Ti = acc[nt][2 * dd + 1];
                    const float rev = (float)(b * d) * (1.0f / 4096.0f); const float cs = __builtin_amdgcn_cosf(rev), sn = __builtin_amdgcn_sinf(rev);
                    *(LAS unsigned*)(tp + (d * 4 + col) * F_TP + 4 * b) = pg8::cvt_pk_bf16(Tr * cs + Ti * sn, Ti * cs - Tr * sn); } }
        }
        LDS_WAIT(); __syncthreads();
#pragma unroll
        for (int mi = 0; mi < 2; ++mi) { const int mt = 2 * wid + mi;
            bf16x8 af[4];
#pragma unroll
            for (int ks = 0; ks < 4; ++ks) af[ks] = *(const LAS bf16x8*)(tp + (16 * mt + fr) * F_TP + ks * 64 + fq * 16);
#pragma unroll
            for (int ct = 0; ct < 4; ++ct) { f32x4 y = {0.f, 0.f, 0.f, 0.f};
#pragma unroll
                for (int ks = 0; ks < 4; ++ks) y = __builtin_amdgcn_mfma_f32_16x16x32_bf16(af[ks], m3f[ct][ks], y, 0, 0, 0);
                const int d = 4 * mt + fq, c = 16 * ct + fr, k = 64 * c + d;
                u32x2 w; w.x = pg8::cvt_pk_bf16(y[0], y[1]); w.y = pg8::cvt_pk_bf16(y[2], y[3]);
                *(GAS u32x2*)(Ycat + (size_t)((n0 >> 10) * SEQ + k) * DM + (n0 & 1023)) = w; } }
    }
    __syncthreads();
}

__device__ __forceinline__ void p2_spatial_unit(LAS unsigned char* lds, const bf16_t* VT, const bf16_t* Ubuf, const float* wsp, const float* bsp, const float* gsgu, bf16_t* Ycat, int b, int n, int h, int tid) {
    const int wid = tid >> 6, lane = tid & 63, fr = lane & 15, fq = lane >> 4;
    LAS float* red = (LAS float*)(lds + 40960);
    LAS float* rstdv = (LAS float*)(lds + 40960 + 4096);
    const int tok0 = b * SEQ + n * 128;
    {
        float s0 = 0.f, s1 = 0.f;
        const bf16_t* p = VT + (size_t)(128 * wid) * MTOK + tok0 + 2 * lane;
#pragma unroll 8
        for (int f = 0; f < 128; ++f) { const unsigned w = *(const GAS unsigned*)(p + (size_t)f * MTOK); const float a = bf2f((unsigned short)(w & 0xffffu)), c = bf2f((unsigned short)(w >> 16)); s0 += a * a; s1 += c * c; }
        red[wid * 128 + 2 * lane] = s0; red[wid * 128 + 2 * lane + 1] = s1;
    }
    bf16x8 af[4];
#pragma unroll
    for (int ks = 0; ks < 4; ++ks) af[ks] = *(const GAS bf16x8*)(VT + (size_t)(h * 128 + 16 * wid + fr) * MTOK + tok0 + ks * 32 + fq * 8);
    LDS_WAIT(); __syncthreads();
    if (tid < 128) { float s = 0.f;
#pragma unroll
        for (int w = 0; w < 8; ++w) s += red[w * 128 + tid];
        rstdv[tid] = 1.0f / sqrtf(s * (1.0f / 1024.0f) + EPS); }
    LDS_WAIT(); __syncthreads();
    const float* wh = wsp + (size_t)h * 128 * 128;
#pragma unroll
    for (int i = 0; i < 8; ++i) { const int piece = tid + i * NTHR, r = piece >> 5, c4 = (piece & 31) * 4; const f32x4 v = *(const GAS f32x4*)(wh + r * 128 + c4); const f32x4 rs = *(const LAS f32x4*)(rstdv + c4);
        u32x2 w; w.x = pk2(v[0] * rs[0], v[1] * rs[1]); w.y = pk2(v[2] * rs[2], v[3] * rs[3]); *(LAS u32x2*)(lds + r * P2_ROWB + c4 * 2) = w; }
    LDS_WAIT(); __syncthreads();
    const int d0 = 16 * wid + 4 * fq;
    const f32x4 gv = *(const GAS f32x4*)(gsgu + h * 128 + d0);
#pragma unroll 4
    for (int nt = 0; nt < 8; ++nt) {
        f32x4 acc = {0.f, 0.f, 0.f, 0.f};
#pragma unroll
        for (int ks = 0; ks < 4; ++ks) { const bf16x8 bfr = *(const LAS bf16x8*)(lds + (16 * nt + fr) * P2_ROWB + ks * 64 + fq * 16); acc = __builtin_amdgcn_mfma_f32_16x16x32_bf16(af[ks], bfr, acc, 0, 0, 0); }
        const int p = 16 * nt + fr; const float bias = bsp[h * 128 + p];
        const u32x2 uw = *(const GAS u32x2*)(Ubuf + (size_t)(tok0 + p) * GW + h * 128 + d0);
        const float u0 = bf2f((unsigned short)(uw.x & 0xffffu)), u1 = bf2f((unsigned short)(uw.x >> 16)), u2 = bf2f((unsigned short)(uw.y & 0xffffu)), u3 = bf2f((unsigned short)(uw.y >> 16));
        u32x2 w; w.x = pg8::cvt_pk_bf16(u0 * (gv[0] * acc[0] + bias), u1 * (gv[1] * acc[1] + bias)); w.y = pg8::cvt_pk_bf16(u2 * (gv[2] * acc[2] + bias), u3 * (gv[3] * acc[3] + bias));
        *(GAS u32x2*)(Ycat + (size_t)(tok0 + p) * DM + FW + h * 128 + d0) = w;
    }
    __syncthreads();
}

__global__ void __launch_bounds__(NTHR, 2) mk_fwd(Args args) {
    extern __shared__ __attribute__((aligned(16))) unsigned char lds_raw[];
    LAS unsigned char* lds = (LAS unsigned char*)lds_raw;
    volatile LAS unsigned* MISC = (volatile LAS unsigned*)(lds + MISC_OFF);
    const int tid = threadIdx.x, lane = tid & 63, wave = __builtin_amdgcn_readfirstlane(tid >> 6);
    const int G = gridDim.x; const int bx = blockIdx.x; const int vcu = (G % 8 == 0) ? (bx % 8) * (G / 8) + bx / 8 : bx;
    unsigned char* ws = args.ws;
    gu32* ctl = (gu32*)(ws + WS_CTL);
    const float* x = args.in[0]; const float* norm_mix = args.in[1]; const float* w_in = args.in[2]; const float* w_fourier = args.in[3]; const float* sgu_norm = args.in[4];
    const float* w_spatial = args.in[5]; const float* b_spatial = args.in[6]; const float* w_out = args.in[7]; const float* norm_ffn = args.in[8];
    const float* w_gate = args.in[9]; const float* w_up = args.in[10]; const float* w_down = args.in[11]; const float* norm_final = args.in[12];
    float* out = args.out;
    bf16_t* Wgu = (bf16_t*)(ws + WS_WGU); bf16_t* Wd = (bf16_t*)(ws + WS_WD); bf16_t* Wout = (bf16_t*)(ws + WS_WOUT);
    bf16_t* Abuf = (bf16_t*)(ws + WS_A); bf16_t* Ubuf = (bf16_t*)(ws + WS_U); bf16_t* VT = (bf16_t*)(ws + WS_VT); bf16_t* XB = (bf16_t*)(ws + WS_XB); bf16_t* Pt = (bf16_t*)(ws + WS_PT);
    bf16_t* Win = (bf16_t*)(ws + WS_WIN); bf16_t* Ycat = (bf16_t*)(ws + WS_YCAT); bf16_t* X1B = (bf16_t*)(ws + WS_X1B); bf16_t* Hb = (bf16_t*)(ws + WS_H);
    float* rstd1 = (float*)(ws + WS_RSTD1); float* ss1 = (float*)(ws + WS_SS1); float* ss2 = (float*)(ws + WS_SS2); bf16_t* CWT = (bf16_t*)(ws + WS_CWT); bf16_t* M1 = (bf16_t*)(ws + WS_M1); bf16_t* M3 = (bf16_t*)(ws + WS_M3);

    for (int u = tid; u < (TAB_OFF - LDSCTL_OFF) / 4; u += NTHR) ((LAS unsigned*)(lds + LDSCTL_OFF))[u] = 0u;
    __syncthreads();
    XcdBarrier bar; bar.bar = (unsigned*)(ctl + CW_BAR); bar.x = 0; bar.st = nullptr;
    if (!MK_PER_PHASE) bar = xcd_barrier_post((unsigned*)(ctl + CW_BAR), MISC + 8);
    const int lo = args.ph_lo, hi = args.ph_hi;
#define IN(k) (lo <= (k) && (k) < hi)
#if defined(MK_PROBE) || defined(MK_PROBE_P7)
#define STAMP(k) do { if (tid == 0) MISC[16 + (k)] = (unsigned)__builtin_amdgcn_s_memrealtime(); } while (0)
#else
#define STAMP(k) do { } while (0)
#endif
#define SEAM(k) do { if (IN(k) && IN((k) + 1)) xcd_barrier(bar); STAMP((k) + 1); } while (0)

    STAMP(0);
    if (IN(0)) {
        const int gw = vcu * NWAVES + wave, NGW = G * NWAVES;
#define P0_XLOAD(v_, m_) do { const GAS f32x4* xr_ = (const GAS f32x4*)(x + (size_t)(m_) * DM) + lane; _Pragma("unroll") for (int j = 0; j < 8; ++j) v_[j] = xr_[64 * j]; } while (0)
#define P0_XDONE(v_, m_) do { float s_ = 0.f; _Pragma("unroll") for (int j = 0; j < 8; ++j) s_ += (v_[j].x * v_[j].x + v_[j].y * v_[j].y) + (v_[j].z * v_[j].z + v_[j].w * v_[j].w); \
            s_ = wave_sum(s_); if (lane == 0) rstd1[m_] = 1.0f / sqrtf(s_ * (1.0f / DM) + EPS); \
            GAS unsigned long long* o8_ = (GAS unsigned long long*)(XB + (size_t)(m_) * DM) + lane; \
            _Pragma("unroll") for (int j = 0; j < 8; ++j) { const f32x4 w_ = v_[j] * gm[j]; o8_[64 * j] = (unsigned long long)pk2(w_.x, w_.y) | ((unsigned long long)pk2(w_.z, w_.w) << 32); } } while (0)
        if (args.p0_mask & 1) { f32x4 va[8], vb[8], gm[8]; int m = gw;
            _Pragma("unroll") for (int j = 0; j < 8; ++j) gm[j] = ((const GAS f32x4*)norm_mix)[lane + 64 * j];
            if (m < MTOK) { P0_XLOAD(va, m);
                for (;;) { const int m1 = m + NGW; if (m1 < MTOK) P0_XLOAD(vb, m1); P0_XDONE(va, m); if (m1 >= MTOK) break;
                           const int m2 = m1 + NGW; if (m2 < MTOK) P0_XLOAD(va, m2); P0_XDONE(vb, m1); if (m2 >= MTOK) break; m = m2; } } }
        if (args.p0_mask & 2) P0_TILES(0, T_EARLY, vcu, G);
        if (args.p0_mask & 4) for (int i = gw * 64 + lane; i < 128 * 128 + 64 * 128; i += NGW * 64) {
            if (i < 128 * 128) { const int dp = i >> 7, k = i & 127, d = dp >> 1, ri = dp & 1, part = k >> 6, a = k & 63; const float rev = (float)((a * d) & 63) * (1.0f / 64.0f);
                const float cs = __builtin_amdgcn_cosf(rev), sn = __builtin_amdgcn_sinf(rev); const float v = ri == 0 ? (part == 0 ? cs : -sn) : (part == 0 ? -sn : -cs);
                M1[i] = (bf16_t)f2bf(v * 0.125f); }
            else { const int q = i - 128 * 128, c = q >> 7, k = q & 127, b = k >> 1, ri = k & 1; const float rev = (float)((b * c) & 63) * (1.0f / 64.0f);
                M3[q] = (bf16_t)f2bf((ri == 0 ? __builtin_amdgcn_cosf(rev) : __builtin_amdgcn_sinf(rev)) * 0.125f); }
        }
        if (args.p0_mask & 8) for (int it = gw; it < 8 * 256; it += NGW) {
            const int h = it >> 8, ep = it & 255, e = ep & 127; const bool sn_ = ep >= 128;
            const float* wf = w_fourier + (size_t)h * 16384 + e; float a0 = 0.f, a1 = 0.f;
            const float wlo = wf[lane * 128], whi = wf[(lane + 64) * 128];
#pragma unroll 8
            for (int j = 0; j < 64; ++j) { const float w0 = __shfl(wlo, j), w1 = __shfl(whi, j);
                const float r00 = (float)((lane * j) & 127) * (1.0f / 128.0f), r01 = (float)((lane * (j + 64)) & 127) * (1.0f / 128.0f);
                const float r10 = (float)(((lane + 64) * j) & 127) * (1.0f / 128.0f), r11 = (float)(((lane + 64) * (j + 64)) & 127) * (1.0f / 128.0f);
                a0 += (sn_ ? __builtin_amdgcn_sinf(r00) : __builtin_amdgcn_cosf(r00)) * w0 + (sn_ ? __builtin_amdgcn_sinf(r01) : __builtin_amdgcn_cosf(r01)) * w1;
                a1 += (sn_ ? __builtin_amdgcn_sinf(r10) : __builtin_amdgcn_cosf(r10)) * w0 + (sn_ ? __builtin_amdgcn_sinf(r11) : __builtin_amdgcn_cosf(r11)) * w1; }
            bf16_t* o = CWT + (size_t)it * 128; o[lane] = (bf16_t)f2bf(a0 * 0.08838834764831845f); o[lane + 64] = (bf16_t)f2bf(a1 * 0.08838834764831845f);
        }
    }
    SEAM(0);

    if (IN(1)) {
        pg8::Order S; S.init(MTOK, INW, DM, G, bx, XB, Win, 8);
        pg8::EpiIn E{Abuf, Ubuf, VT, rstd1};
        pg8::gemm_phase<pg8::EpiIn, pg8::Order, true, true>(lds + RING_OFF, DM, S, E);
        { const int two = (MTOK / 256) * (INW / 256) - G; if (bx >= two) P0_TILES(T_EARLY, T_EARLY + T_OUT + 2 * T_G, bx - two, G - two); }
    }
    SEAM(1);

    if (IN(2)) {
        for (int i = 0; i < 2; ++i) { const int j = vcu * 2 + i; if (j < 512) { const int h = j & 7, bn = j >> 3; p2_spatial_unit(lds, VT, Ubuf, w_spatial, b_spatial, sgu_norm, Ycat, bn >> 5, bn & 31, h, tid); } }
        for (int i = 0; i < 2; ++i) { const int j = vcu * 2 + i; if (j < 512) { const int h = j & 7, rest = j >> 3; p2_daxis_unit(lds, Abuf, CWT, Pt, rest >> 5, h, (rest >> 2) & 7, rest & 3, tid); } }
        if (G != 256) { for (int j = 2 * G + vcu; j < 512; j += G) { const int h = j & 7, bn = j >> 3; p2_spatial_unit(lds, VT, Ubuf, w_spatial, b_spatial, sgu_norm, Ycat, bn >> 5, bn & 31, h, tid); p2_daxis_unit(lds, Abuf, CWT, Pt, bn >> 5, h, (bn >> 2) & 7, bn & 3, tid); } }
    }
    SEAM(2);

    if (IN(3)) {
        p3_fft_phase(lds, Pt, M1, M3, Ycat, vcu, G, tid);
    }
    SEAM(3);

    if (IN(4)) {
        pg8::Order S; S.init(MTOK, DM, DM, G, bx, Ycat, Wout);
        pg8::EpiRes<true> E{x, out, X1B, ss1, args.skip_epi, norm_ffn};
        pg8::gemm_phase<pg8::EpiRes<true>, pg8::Order, false, true>(lds + RING_OFF, DM, S, E);
    }
    SEAM(4);

    if (IN(5)) {
        pg8::Order S; S.init(MTOK, NGU, DM, G, bx, X1B, Wgu);
        pg8::EpiGU E{Hb, ss1};
        pg8::gemm_phase<pg8::EpiGU, pg8::Order, true, true>(lds + RING_OFF, DM, S, E);
        { const int nu = (MTOK / 256) * (NGU / 256), more = nu % G; if (more == 0) { P0_TILES(T_EARLY + T_OUT + 2 * T_G, T_ALL, bx, G); } else if (bx >= more) P0_TILES(T_EARLY + T_OUT + 2 * T_G, T_ALL, bx - more, G - more); }
    }
    SEAM(5);

    if (IN(6)) {
        pg8::Order S; S.init(MTOK, DM, DFF, G, bx, Hb, Wd);
        pg8::EpiRes<false> E{out, out, nullptr, ss2, args.skip_epi, nullptr};
        pg8::gemm_phase<pg8::EpiRes<false>, pg8::Order, false, true>(lds + RING_OFF, DFF, S, E);
    }
    SEAM(6);

    if (IN(7)) {
        const int gw = vcu * NWAVES + wave, NGW = G * NWAVES;
#ifdef MK_PROBE
        __syncthreads();
        const float dA = (float)(MISC[16 + MK_PROBE_B + 1] - MISC[16 + MK_PROBE_A]) * 0.01f * MK_PROBE_SCALE, dB = (float)(MISC[16 + MK_PROBE_B + 1] - MISC[16 + MK_PROBE_B]) * 0.01f;
        (void)dB;
#endif
        f32x4 gf[8];
#pragma unroll
        for (int j = 0; j < 8; ++j) gf[j] = ((const GAS f32x4*)norm_final)[lane + 64 * j];
        for (int m = gw; m < MTOK; m += NGW) {
            const f32x4 p0 = *(const GAS f32x4*)(ss2 + (size_t)m * 8), p1 = *(const GAS f32x4*)(ss2 + (size_t)m * 8 + 4);
            const float ss = ((p0[0] + p0[1]) + (p0[2] + p0[3])) + ((p1[0] + p1[1]) + (p1[2] + p1[3]));
            const float r = 1.0f / sqrtf(ss * (1.0f / DM) + EPS);
            GAS f32x4* xr = (GAS f32x4*)(out + (size_t)m * DM) + lane; GAS f32x4* xw = args.p7_dummy ? (GAS f32x4*)((float*)(ws + WS_ADFT) + (size_t)m * DM) + lane : xr;
#pragma unroll
            for (int j = 0; j < 8; ++j) { f32x4 v = xr[64 * j]; v = v * r * gf[j];
#ifdef MK_PROBE
                if (m == 0 && lane == 0 && j == 0) v.x += dA * 0.001f;
#endif
                xw[64 * j] = v; }
        }
#ifdef MK_PROBE_P7
        asm volatile("s_waitcnt vmcnt(0)" ::: "memory");
        if (gw == 0 && lane == 0) out[1] += (float)((unsigned)__builtin_amdgcn_s_memrealtime() - MISC[16 + 7]) * 0.01f * 0.001f;
#endif
    }
#undef IN
#undef SEAM
}

static void launch(hipStream_t stream, void* const* d_in, void* d_out, void* d_ws) {
    static int grid = 0;
    if (grid == 0) {
        int dev = 0, cus = 0;
        if (hipGetDevice(&dev) != hipSuccess || hipDeviceGetAttribute(&cus, hipDeviceAttributeMultiprocessorCount, dev) != hipSuccess) { fprintf(stderr, "kernel_launch: device query failed\n"); grid = -1; return; }
        if (hipFuncSetAttribute((const void*)mk_fwd, hipFuncAttributeMaxDynamicSharedMemorySize, LDS_BYTES) != hipSuccess) { fprintf(stderr, "kernel_launch: hipFuncSetAttribute failed\n"); grid = -1; return; }
        int per_cu = 0;
        if (hipOccupancyMaxActiveBlocksPerMultiprocessor(&per_cu, (const void*)mk_fwd, NTHR, LDS_BYTES) != hipSuccess || per_cu < 1) fprintf(stderr, "kernel_launch: occupancy query reports %d workgroups per CU\n", per_cu);
        (void)hipGetLastError();
        grid = cus;
        if (grid != 256) fprintf(stderr, "kernel_launch: %d CUs; this kernel is laid out for 256 (the one-unit-per-workgroup phases need exactly 256 workgroups)\n", grid);
        grid = 256;
    }
    if (grid < 0) return;
    if (hipMemsetAsync((char*)d_ws + WS_CTL, 0, CTL_ZERO_BYTES, stream) != hipSuccess) { fprintf(stderr, "kernel_launch: memset failed\n"); return; }
#ifdef MK_EXTRA_MEMSET
    for (int q = 0; q < MK_EXTRA_MEMSET; ++q) (void)hipMemsetAsync((char*)d_ws + 254 * MiB + q * 65536, 0, CTL_ZERO_BYTES, stream);
#endif
    Args a{};
    for (int i = 0; i < 13; ++i) a.in[i] = (const float*)d_in[i];
    a.out = (float*)d_out; a.ws = (unsigned char*)d_ws; a.p7_dummy = 0; a.p0_mask = 15;
#if MK_PER_PHASE
    for (int p = 0; p < NPHASE; ++p) { a.ph_lo = p; a.ph_hi = p + 1; for (int r = 0; r < (p == MK_REPEAT ? 2 : 1); ++r) { a.p7_dummy = (p == 7 && MK_REPEAT == 7 && r == 0) ? 1 : 0; a.p0_mask = (p == 0 && r == 1) ? MK_P0MASK : 15; a.skip_epi = (r == 1 && (p == 4 || p == 6)) ? 1 : 0; hipLaunchKernelGGL(mk_fwd, dim3(grid), dim3(NTHR), LDS_BYTES, stream, a); } }
#else
    a.ph_lo = 0; a.ph_hi = NPHASE; hipLaunchKernelGGL(mk_fwd, dim3(grid), dim3(NTHR), LDS_BYTES, stream, a);
#endif
    const hipError_t le = hipPeekAtLastError();
    if (le != hipSuccess) fprintf(stderr, "kernel_launch: launch failed: %s\n", hipGetErrorName(le));
}
}
extern "C" void kernel_launch(void* const* d_in, const int* in_sizes, int n_in, void* d_out, int out_size, void* d_ws, size_t ws_size, hipStream_t stream) {
    (void)in_sizes; (void)n_in; (void)out_size; (void)ws_size;
    fp::launch(stream, d_in, d_out, d_ws);
}
```
